# Optimizing an MI355X kernel written in HIP

```python
import jax, jax.numpy as jnp
from jax import lax
import numpy as np

D_MODEL = 4096
BATCH = 4
SEQ = 4096
DEPTH = 1
DEC_BATCH = 1
DEC_SEQ = 16384
PAST_LEN = 128

HEAD_DIM = 128
D_MIX = D_MODEL
ATTN_WIDTH = D_MIX // 2
N_Q_HEADS = ATTN_WIDTH // HEAD_DIM
N_KV_HEADS = N_Q_HEADS // 4
KV_GROUP = N_Q_HEADS // N_KV_HEADS
KV_WIDTH = N_KV_HEADS * HEAD_DIM
CONV_WIDTH = D_MIX - ATTN_WIDTH
CONV_GROUPS = CONV_WIDTH // HEAD_DIM
CONV_K = 3
IN_PROJ_WIDTH = ATTN_WIDTH + 2 * KV_WIDTH + 3 * CONV_WIDTH
D_FF = 11008
GRID_W = 64
ROPE_AXIS_DIM = HEAD_DIM // 2
ROPE_THETA = 10000.0
Q_BLOCK = 128
NORM_EPS = 1e-6
FFN_RES_SCALE = 0.5

kernel_name = 'hymba_macaron_gqa_shortconv_encoder'


def rms_norm(x, g):
    xf = x.astype(jnp.float32)
    y = xf * lax.rsqrt(jnp.mean(xf * xf, axis=-1, keepdims=True) + NORM_EPS)
    return (y * g.astype(jnp.float32)).astype(x.dtype)


def swiglu(x, w_gate, w_up, w_down):
    return (jax.nn.silu(x @ w_gate) * (x @ w_up)) @ w_down


def axial_rope_angles(seq_len):
    rows = seq_len // GRID_W
    inv = 1.0 / (ROPE_THETA ** (jnp.arange(0, ROPE_AXIS_DIM, 2, dtype=jnp.float32) / ROPE_AXIS_DIM))
    row_ang = jnp.arange(rows, dtype=jnp.float32)[:, None] * inv
    col_ang = jnp.arange(GRID_W, dtype=jnp.float32)[:, None] * inv
    ang = jnp.concatenate([
        jnp.broadcast_to(row_ang[:, None, :], (rows, GRID_W, inv.shape[0])),
        jnp.broadcast_to(col_ang[None, :, :], (rows, GRID_W, inv.shape[0])),
    ], axis=-1)
    return ang.reshape(rows * GRID_W, ROPE_AXIS_DIM)


def apply_rope(x, cos, sin):
    xf = x.astype(jnp.float32)
    x1, x2 = xf[..., :ROPE_AXIS_DIM], xf[..., ROPE_AXIS_DIM:]
    c, s = cos[None, :, None, :], sin[None, :, None, :]
    return jnp.concatenate([x1 * c - x2 * s, x2 * c + x1 * s], axis=-1).astype(x.dtype)


def block_attention(q, k, v):
    b, s_len = q.shape[0], q.shape[1]
    n_blk = s_len // Q_BLOCK
    scale = HEAD_DIM ** -0.5
    qb = q.reshape(b, n_blk, Q_BLOCK, N_KV_HEADS, KV_GROUP, HEAD_DIM).transpose(1, 0, 2, 3, 4, 5)

    def one_block(q_blk):
        s = jnp.einsum('bqkgd,bskd->bkgqs', q_blk, k).astype(jnp.float32) * scale
        p = jax.nn.softmax(s, axis=-1).astype(v.dtype)
        return jnp.einsum('bkgqs,bskd->bqkgd', p, v)

    o = lax.map(one_block, qb)
    return o.transpose(1, 0, 2, 3, 4, 5).reshape(b, s_len, ATTN_WIDTH)


def short_conv(u, w):
    s_len = u.shape[1]
    up = jnp.pad(u, ((0, 0), (1, 1), (0, 0)))
    return w[0] * up[:, 0:s_len] + w[1] * up[:, 1:s_len + 1] + w[2] * up[:, 2:s_len + 2]


def encoder_layer(x, cos, sin, ffn1_pre, ffn1_post, w1_gate, w1_up, w1_down,
                  mix_pre, mix_post, w_in, q_norm, k_norm, conv_w, attn_out_norm,
                  conv_out_norm, w_out, ffn2_pre, ffn2_post, w2_gate, w2_up, w2_down):
    b, s_len = x.shape[0], x.shape[1]
    h = swiglu(rms_norm(x, ffn1_pre), w1_gate, w1_up, w1_down)
    x = x + FFN_RES_SCALE * rms_norm(h, ffn1_post)
    h = rms_norm(x, mix_pre)
    proj = h @ w_in
    o1 = ATTN_WIDTH
    o2 = o1 + KV_WIDTH
    o3 = o2 + KV_WIDTH
    o4 = o3 + CONV_WIDTH
    o5 = o4 + CONV_WIDTH
    q = proj[..., :o1].reshape(b, s_len, N_Q_HEADS, HEAD_DIM)
    k = proj[..., o1:o2].reshape(b, s_len, N_KV_HEADS, HEAD_DIM)
    v = proj[..., o2:o3].reshape(b, s_len, N_KV_HEADS, HEAD_DIM)
    gate_b = proj[..., o3:o4]
    gate_c = proj[..., o4:o5]
    h_conv = proj[..., o5:]
    q = apply_rope(rms_norm(q, q_norm), cos, sin)
    k = apply_rope(rms_norm(k, k_norm), cos, sin)
    attn = rms_norm(block_attention(q, k, v), attn_out_norm)
    conv = rms_norm(gate_b * short_conv(gate_c * h_conv, conv_w), conv_out_norm)
    mixed = jnp.concatenate([attn, conv], axis=-1) @ w_out
    x = x + rms_norm(mixed, mix_post)
    h = swiglu(rms_norm(x, ffn2_pre), w2_gate, w2_up, w2_down)
    x = x + FFN_RES_SCALE * rms_norm(h, ffn2_post)
    return x


def run_trunk(x, ffn1_pre, ffn1_post, w1_gate, w1_up, w1_down, mix_pre, mix_post,
              w_in, q_norm, k_norm, conv_w, attn_out_norm, conv_out_norm, w_out,
              ffn2_pre, ffn2_post, w2_gate, w2_up, w2_down):
    ang = axial_rope_angles(x.shape[1])
    cos, sin = jnp.cos(ang), jnp.sin(ang)
    for l in range(DEPTH):
        x = encoder_layer(x, cos, sin, ffn1_pre[l], ffn1_post[l], w1_gate[l], w1_up[l], w1_down[l],
                          mix_pre[l], mix_post[l], w_in[l], q_norm[l], k_norm[l], conv_w[l],
                          attn_out_norm[l], conv_out_norm[l], w_out[l],
                          ffn2_pre[l], ffn2_post[l], w2_gate[l], w2_up[l], w2_down[l])
    return x


def setup_inputs(seed: int = 0) -> dict:
    key = jax.random.key(seed)
    ks = jax.random.split(key, 24)

    def w(k, shape, fan_in):
        return jax.random.normal(k, shape, jnp.float32) * (fan_in ** -0.5)

    def gain(k, n):
        return 1.0 + 0.1 * jax.random.normal(k, (DEPTH, n), jnp.float32)

    return {
        'x_prompt': jax.random.normal(ks[0], (BATCH, SEQ, D_MODEL), jnp.float32),
        'x_sample': jax.random.normal(ks[1], (DEC_BATCH, DEC_SEQ, D_MODEL), jnp.float32),
        'ffn1_pre': gain(ks[2], D_MODEL),
        'ffn1_post': gain(ks[3], D_MODEL),
        'w1_gate': w(ks[4], (DEPTH, D_MODEL, D_FF), D_MODEL),
        'w1_up': w(ks[5], (DEPTH, D_MODEL, D_FF), D_MODEL),
        'w1_down': w(ks[6], (DEPTH, D_FF, D_MODEL), D_FF),
        'mix_pre': gain(ks[7], D_MODEL),
        'mix_post': gain(ks[8], D_MODEL),
        'w_in': w(ks[9], (DEPTH, D_MODEL, IN_PROJ_WIDTH), D_MODEL),
        'q_norm': gain(ks[10], HEAD_DIM),
        'k_norm': gain(ks[11], HEAD_DIM),
        'conv_w': w(ks[12], (DEPTH, CONV_K, CONV_WIDTH), CONV_K),
        'attn_out_norm': gain(ks[13], ATTN_WIDTH),
        'conv_out_norm': gain(ks[14], CONV_WIDTH),
        'w_out': w(ks[15], (DEPTH, D_MIX, D_MODEL), D_MIX),
        'ffn2_pre': gain(ks[16], D_MODEL),
        'ffn2_post': gain(ks[17], D_MODEL),
        'w2_gate': w(ks[18], (DEPTH, D_MODEL, D_FF), D_MODEL),
        'w2_up': w(ks[19], (DEPTH, D_MODEL, D_FF), D_MODEL),
        'w2_down': w(ks[20], (DEPTH, D_FF, D_MODEL), D_FF),
    }


def reference(x_prompt, x_sample, ffn1_pre, ffn1_post, w1_gate, w1_up, w1_down,
              mix_pre, mix_post, w_in, q_norm, k_norm, conv_w, attn_out_norm,
              conv_out_norm, w_out, ffn2_pre, ffn2_post, w2_gate, w2_up, w2_down):
    y_prompt = run_trunk(x_prompt, ffn1_pre, ffn1_post, w1_gate, w1_up, w1_down, mix_pre, mix_post,
                         w_in, q_norm, k_norm, conv_w, attn_out_norm, conv_out_norm, w_out,
                         ffn2_pre, ffn2_post, w2_gate, w2_up, w2_down)
    y_sample = run_trunk(x_sample, ffn1_pre, ffn1_post, w1_gate, w1_up, w1_down, mix_pre, mix_post,
                         w_in, q_norm, k_norm, conv_w, attn_out_norm, conv_out_norm, w_out,
                         ffn2_pre, ffn2_post, w2_gate, w2_up, w2_down)
    return (y_prompt, y_sample)
```

```cpp
#include <hip/hip_runtime.h>
#include <cstdio>
#include <cstdint>
namespace pg8 {
#define PG8_LAS __attribute__((address_space(3)))
typedef unsigned short bf16_t;
typedef short bf16x8 __attribute__((ext_vector_type(8)));
typedef float f32x4 __attribute__((ext_vector_type(4)));
typedef unsigned u32x4 __attribute__((ext_vector_type(4)));
constexpr int BM = 256, BK = 64, HALF = 128, HTB = HALF * BK * 2  , STAGE_BYTES = 8 * HTB, NXCD = 8, WGM = 8;

__host__ __device__ __forceinline__ int lds_byte(int r, int c) { const int st = (r >> 4) * 2 + (c >> 5), rr = r & 15, cc = c & 31, ob = rr * 64 + cc * 2; return st * 1024 + (ob ^ (((ob >> 9) & 1) << 5)); }
__host__ __device__ __forceinline__ void stage_rc(int b, int& R, int& C) { const int st = b / 1024, sb = b % 1024, swz = sb ^ (((sb >> 9) & 1) << 5); R = (st >> 1) * 16 + swz / 64; C = (st & 1) * 32 + (swz % 64) / 2; }
__host__ __device__ __forceinline__ int perm32(int rho) { const int n = rho >> 4, i = rho & 15; return 8 * (i >> 2) + 4 * n + (i & 3); }

struct Unit { int pm, pn; };
struct Gemm { const bf16_t* A; const bf16_t* Bt; int M, N, K; };

struct StaticOrder {
    int nM, nN, nwg, G, c;
    __host__ __device__ void init(int M, int N, int G_, int c_) { nM = M / BM; nN = N / BM; nwg = nM * nN; G = G_; c = c_; }
    __host__ __device__ bool next(int i, Unit& u) const {
        const long L = (long)i * G + c; if (L >= nwg) return false;
        int wgid = (int)L; { const int q = nwg / NXCD, r = nwg % NXCD, xcd = wgid % NXCD, off = wgid / NXCD; wgid = (xcd < r ? xcd * (q + 1) : r * (q + 1) + (xcd - r) * q) + off; }
        const int nig = WGM * nN, gid = wgid / nig, fm = gid * WGM, gsz = (nM - fm) < WGM ? (nM - fm) : WGM;
        u.pm = fm + ((wgid % nig) % gsz); u.pn = (wgid % nig) / gsz; return true;
    }
    __device__ __forceinline__ void a_ready(const Unit&) const {}
    __device__ __forceinline__ void done(const Unit&) const {}
};

__device__ __forceinline__ unsigned cvt_pk_bf16(float lo, float hi) { unsigned r; asm volatile("v_cvt_pk_bf16_f32 %0, %1, %2" : "=v"(r) : "v"(lo), "v"(hi)); return r; }

struct EpiBf16 {
    static constexpr bool PERM = true, AFTER_DRAIN = false;
    bf16_t* O; int ldc;
    __device__ __forceinline__ void operator()(const f32x4 (&acc)[2][2][4][2], const Unit& u, int wr, int wc, int fr, int fq) const {
        const int row0 = u.pm * BM + wr * 64 + fr, col0 = u.pn * BM + wc * 32 + 8 * fq;
#pragma unroll
        for (int ai = 0; ai < 2; ++ai)
#pragma unroll
            for (int m = 0; m < 4; ++m) { bf16_t* rowp = O + (size_t)(row0 + ai * HALF + m * 16) * ldc + col0;
#pragma unroll
                for (int bj = 0; bj < 2; ++bj) { const f32x4 v0 = acc[ai][bj][m][0], v1 = acc[ai][bj][m][1];
                    u32x4 w; w.x = cvt_pk_bf16(v0[0], v0[1]); w.y = cvt_pk_bf16(v0[2], v0[3]); w.z = cvt_pk_bf16(v1[0], v1[1]); w.w = cvt_pk_bf16(v1[2], v1[3]);
                    *(u32x4*)(rowp + bj * HALF) = w; } }
    }
};
__device__ __forceinline__ float silu_mul(float g, float u) { return g * u * __builtin_amdgcn_rcpf(1.0f + __builtin_amdgcn_exp2f(-1.4426950408889634f * g)); }
struct EpiSwiGLU {
    static constexpr bool PERM = true, AFTER_DRAIN = false;
    bf16_t* O; int ldc;
    __device__ __forceinline__ void operator()(const f32x4 (&acc)[2][2][4][2], const Unit& u, int wr, int wc, int fr, int fq) const {
        const int row0 = u.pm * BM + wr * 64 + fr, col0 = u.pn * HALF + wc * 32 + 8 * fq;
#pragma unroll
        for (int ai = 0; ai < 2; ++ai)
#pragma unroll
            for (int m = 0; m < 4; ++m) { bf16_t* rowp = O + (size_t)(row0 + ai * HALF + m * 16) * ldc + col0;
                const f32x4 g0 = acc[ai][0][m][0], g1 = acc[ai][0][m][1], u0 = acc[ai][1][m][0], u1 = acc[ai][1][m][1];
                u32x4 w; w.x = cvt_pk_bf16(silu_mul(g0[0], u0[0]), silu_mul(g0[1], u0[1])); w.y = cvt_pk_bf16(silu_mul(g0[2], u0[2]), silu_mul(g0[3], u0[3]));
                w.z = cvt_pk_bf16(silu_mul(g1[0], u1[0]), silu_mul(g1[1], u1[1])); w.w = cvt_pk_bf16(silu_mul(g1[2], u1[2]), silu_mul(g1[3], u1[3]));
                *(u32x4*)rowp = w; }
    }
};

template <class Epi, class Sched, bool ALIGN_EPI = false, bool SP2 = false>
__device__ __forceinline__ void gemm_phase(PG8_LAS unsigned char* lds, const Gemm g, const Sched& S, const Epi& E) {
    const int tid = threadIdx.x, wid = __builtin_amdgcn_readfirstlane(tid >> 6), lane = tid & 63, wr = wid >> 2, wc = wid & 3, fr = lane & 15, fq = lane >> 4;
    const int K = g.K, nt = K / BK;
    unsigned voffA[2], voffB[2];
#pragma unroll
    for (int i = 0; i < 2; ++i) { int R, C; stage_rc(tid * 16 + i * 8192, R, C); const int Rb = Epi::PERM ? ((R & ~31) + perm32(R & 31)) : R;
        voffA[i] = (unsigned)(R * K + C) * 2u; voffB[i] = (unsigned)(Rb * K + C) * 2u; }
    const size_t kstep = (size_t)(BK * 2);
    const size_t hstep = (size_t)HALF * K * 2;
    const size_t tstep = 2 * hstep;
    const unsigned ldsw = (unsigned)wid * 1024u;
    const int aoff = lds_byte(wr * 64 + fr, fq * 8), boff = lds_byte(wc * 32 + fr, fq * 8);
#define PG8_SA(b, h) (((b) * 2 + (h)) * HTB)
#define PG8_SB(b, h) ((4 + (b) * 2 + (h)) * HTB)
#define PG8_STAGE(bufoff, gbase, voff) do { _Pragma("unroll") for (int _i = 0; _i < 2; ++_i) \
        __builtin_amdgcn_global_load_lds((const unsigned*)((const char*)(gbase) + (voff)[_i]), (PG8_LAS unsigned*)(lds + (bufoff) + ldsw + _i * 8192), 16, 0, 0); } while (0)
#define PG8_LDA(dst, b, h) do { _Pragma("unroll") for (int m = 0; m < 4; ++m) _Pragma("unroll") for (int k = 0; k < 2; ++k) dst[m][k] = *(const PG8_LAS bf16x8*)(lds + PG8_SA(b, h) + aoff + m * 2048 + k * 1024); } while (0)
#define PG8_LDB(dst, b, h) do { _Pragma("unroll") for (int n = 0; n < 2; ++n) _Pragma("unroll") for (int k = 0; k < 2; ++k) dst[n][k] = *(const PG8_LAS bf16x8*)(lds + PG8_SB(b, h) + boff + n * 2048 + k * 1024); } while (0)
#define PG8_MMA(ai, bj, At, Bt) do { __builtin_amdgcn_s_setprio(1); _Pragma("unroll") for (int m = 0; m < 4; ++m) _Pragma("unroll") for (int n = 0; n < 2; ++n) _Pragma("unroll") for (int k = 0; k < 2; ++k) \
        acc[ai][bj][m][n] = __builtin_amdgcn_mfma_f32_16x16x32_bf16(Bt[n][k], At[m][k], acc[ai][bj][m][n], 0, 0, 0); __builtin_amdgcn_s_setprio(0); } while (0)
#define PG8_WAIT_V(n) asm volatile("s_waitcnt vmcnt(" #n ")" ::: "memory")
#define PG8_WAIT_L(n) asm volatile("s_waitcnt lgkmcnt(" #n ")" ::: "memory")
#define PG8_BAR __builtin_amdgcn_s_barrier()
#define PG8_SCHED __builtin_amdgcn_sched_barrier(0)
    Unit cur, nxt; int ui = 0;
    if (!S.next(0, cur)) return;
    f32x4 acc[2][2][4][2];
#pragma unroll
    for (int a = 0; a < 2; ++a)
#pragma unroll
        for (int b = 0; b < 2; ++b)
#pragma unroll
            for (int m = 0; m < 4; ++m)
#pragma unroll
                for (int n = 0; n < 2; ++n) acc[a][b][m][n] = (f32x4){0.f, 0.f, 0.f, 0.f};
    bf16x8 At[4][2], B0[2][2], B1[2][2];
    const char* cA = (const char*)g.A + (size_t)cur.pm * tstep; const char* cB = (const char*)g.Bt + (size_t)cur.pn * tstep;
    S.a_ready(cur);
    if constexpr (SP2) {
        PG8_STAGE(PG8_SB(0, 0), cB, voffB); PG8_STAGE(PG8_SB(0, 1), cB + hstep, voffB); PG8_STAGE(PG8_SA(0, 0), cA, voffA); PG8_STAGE(PG8_SA(0, 1), cA + hstep, voffA);
        if (wr == 1) PG8_BAR;
        PG8_WAIT_V(2); PG8_BAR;
        PG8_STAGE(PG8_SB(1, 0), cB + kstep, voffB); PG8_STAGE(PG8_SA(1, 0), cA + kstep, voffA); PG8_STAGE(PG8_SB(1, 1), cB + hstep + kstep, voffB);
        PG8_WAIT_V(6); PG8_BAR;
    } else {
        PG8_STAGE(PG8_SB(0, 0), cB, voffB); PG8_STAGE(PG8_SA(0, 0), cA, voffA); PG8_STAGE(PG8_SB(0, 1), cB + hstep, voffB); PG8_STAGE(PG8_SA(0, 1), cA + hstep, voffA);
        if (wr == 1) PG8_BAR;
        PG8_WAIT_V(4); PG8_BAR;
        PG8_STAGE(PG8_SB(1, 0), cB + kstep, voffB); PG8_STAGE(PG8_SA(1, 0), cA + kstep, voffA); PG8_STAGE(PG8_SB(1, 1), cB + hstep + kstep, voffB);
        PG8_WAIT_V(6); PG8_BAR;
    }
    for (;;) {
        const bool has_next = S.next(ui + 1, nxt);
        const char* nA = has_next ? (const char*)g.A + (size_t)nxt.pm * tstep : cA; const char* nB = has_next ? (const char*)g.Bt + (size_t)nxt.pn * tstep : cB;
        for (int t = 0; t < nt; t += 2) {
            const bool last = (t == nt - 2);
            const char* a1 = cA + (size_t)(t + 1) * kstep;
            const char* a2 = last ? nA : cA + (size_t)(t + 2) * kstep; const char* b2 = last ? nB : cB + (size_t)(t + 2) * kstep;
            const char* a3 = a2 + kstep; const char* b3 = b2 + kstep;
            if (last && has_next) S.a_ready(nxt);
            if constexpr (SP2) {
            PG8_LDB(B0, 0, 0); PG8_LDB(B1, 0, 1); PG8_SCHED; PG8_LDA(At, 0, 0); PG8_STAGE(PG8_SA(1, 1), a1 + hstep, voffA);
            PG8_WAIT_V(8); PG8_WAIT_L(0); PG8_BAR; PG8_MMA(0, 0, At, B0); PG8_MMA(0, 1, At, B1); PG8_BAR; PG8_SCHED;
            PG8_LDA(At, 0, 1); PG8_STAGE(PG8_SB(0, 0), b2, voffB); PG8_STAGE(PG8_SB(0, 1), b2 + hstep, voffB); PG8_STAGE(PG8_SA(0, 0), a2, voffA);
            PG8_WAIT_V(8); PG8_WAIT_L(0); PG8_BAR; PG8_MMA(1, 0, At, B0); PG8_MMA(1, 1, At, B1); PG8_BAR; PG8_SCHED;
            PG8_LDB(B0, 1, 0); PG8_LDB(B1, 1, 1); PG8_SCHED; PG8_LDA(At, 1, 0); PG8_STAGE(PG8_SA(0, 1), a2 + hstep, voffA);
            PG8_WAIT_V(8); PG8_WAIT_L(0); PG8_BAR; PG8_MMA(0, 0, At, B0); PG8_MMA(0, 1, At, B1); PG8_BAR; PG8_SCHED;
            PG8_LDA(At, 1, 1); PG8_STAGE(PG8_SB(1, 0), b3, voffB); PG8_STAGE(PG8_SB(1, 1), b3 + hstep, voffB); PG8_STAGE(PG8_SA(1, 0), a3, voffA);
            PG8_WAIT_V(8); PG8_WAIT_L(0); PG8_BAR; PG8_MMA(1, 0, At, B0); PG8_MMA(1, 1, At, B1); PG8_BAR; PG8_SCHED;
            } else {
            PG8_LDB(B0, 0, 0); PG8_SCHED; PG8_LDA(At, 0, 0); PG8_STAGE(PG8_SA(1, 1), a1 + hstep, voffA);
            PG8_WAIT_L(8); PG8_BAR; PG8_WAIT_L(0); PG8_MMA(0, 0, At, B0); PG8_BAR; PG8_SCHED;
            PG8_LDB(B1, 0, 1); PG8_STAGE(PG8_SB(0, 0), b2, voffB);
            PG8_BAR; PG8_WAIT_L(0); PG8_MMA(0, 1, At, B1); PG8_BAR;
            PG8_LDA(At, 0, 1); PG8_STAGE(PG8_SA(0, 0), a2, voffA);
            PG8_BAR; PG8_WAIT_L(0); PG8_MMA(1, 0, At, B0); PG8_BAR; PG8_SCHED;
            PG8_STAGE(PG8_SB(0, 1), b2 + hstep, voffB);
            PG8_WAIT_V(6); PG8_BAR; PG8_MMA(1, 1, At, B1); PG8_BAR;
            PG8_LDB(B0, 1, 0); PG8_SCHED; PG8_LDA(At, 1, 0); PG8_STAGE(PG8_SA(0, 1), a2 + hstep, voffA);
            PG8_WAIT_L(8); PG8_BAR; PG8_WAIT_L(0); PG8_MMA(0, 0, At, B0); PG8_BAR; PG8_SCHED;
            PG8_LDB(B1, 1, 1); PG8_STAGE(PG8_SB(1, 0), b3, voffB);
            PG8_BAR; PG8_WAIT_L(0); PG8_MMA(0, 1, At, B1); PG8_BAR;
            PG8_LDA(At, 1, 1); PG8_STAGE(PG8_SA(1, 0), a3, voffA);
            PG8_BAR; PG8_WAIT_L(0); PG8_MMA(1, 0, At, B0); PG8_BAR; PG8_SCHED;
            PG8_STAGE(PG8_SB(1, 1), b3 + hstep, voffB);
            PG8_WAIT_V(6); PG8_BAR; PG8_MMA(1, 1, At, B1); PG8_BAR;
            }
        }
        if constexpr (ALIGN_EPI) { if (wr == 0) PG8_BAR; }
        if constexpr (!Epi::AFTER_DRAIN) { E(acc, cur, wr, wc, fr, fq); S.done(cur); }
        if (!has_next) break;
#pragma unroll
        for (int a = 0; a < 2; ++a)
#pragma unroll
            for (int b = 0; b < 2; ++b)
#pragma unroll
                for (int m = 0; m < 4; ++m)
#pragma unroll
                    for (int n = 0; n < 2; ++n) acc[a][b][m][n] = (f32x4){0.f, 0.f, 0.f, 0.f};
        cur = nxt; cA = nA; cB = nB; ++ui;
        if constexpr (ALIGN_EPI) { if (wr == 1) PG8_BAR; }
    }
    PG8_WAIT_V(0);
    if constexpr (!ALIGN_EPI) { if (wr == 0) PG8_BAR; }
    PG8_BAR;
    if constexpr (Epi::AFTER_DRAIN) { E.fused(acc, cur, wr, wc, fr, fq, lds, wid, lane); S.done(cur); }
#undef PG8_SA
#undef PG8_SB
#undef PG8_STAGE
#undef PG8_LDA
#undef PG8_LDB
#undef PG8_MMA
#undef PG8_WAIT_V
#undef PG8_WAIT_L
#undef PG8_BAR
#undef PG8_SCHED
}
}
namespace attn {
using bf16 = unsigned short;
constexpr int   D = 128, NW = 8, QBLK = 32, KVBLK = 64;
constexpr float SCALE = 0.088388347648318440f;
constexpr float THR = 8.f;
constexpr int SDEPTH = 2;
constexpr int LDQ = 9216, LDK = 9216, LDO = 2048;
constexpr size_t SHM_V = KVBLK * D * 2, SHM_K = KVBLK * D * 2, SHM_ATTN = 2 * SHM_V + 2 * SHM_K + NW * 64 * 4;
#define LD8(p) (*reinterpret_cast<const bf16x8*>(p))
using bf16x8 = __attribute__((ext_vector_type(8))) short;
using s16x4  = __attribute__((ext_vector_type(4))) short;
using f32x16 = __attribute__((ext_vector_type(16))) float;
using f32x8  = __attribute__((ext_vector_type(8))) float;
using u32x4  = __attribute__((ext_vector_type(4))) unsigned;
#define KSWZ(row, colB) ((row) * 256 + ((colB) ^ (((row) & 7) << 4)))
#define SBAR() __builtin_amdgcn_sched_barrier(0)
__device__ __forceinline__ int crow(int r, int hi) { return (r & 3) + 8 * (r >> 2) + 4 * hi; }
__device__ __forceinline__ unsigned cvtpk(float lo, float hi) {
  unsigned r; asm volatile("v_cvt_pk_bf16_f32 %0, %1, %2" : "=v"(r) : "v"(lo), "v"(hi)); return r;
}
__device__ __forceinline__ void partialSM(f32x16& p0, f32x16& p1, float& m_reg, float& mn, float& alpha) {
  constexpr float C = SCALE * 1.4426950408889634f;
  float pmax = p0[0]; for (int r = 1; r < 16; ++r) pmax = fmaxf(pmax, p0[r]); for (int r = 0; r < 16; ++r) pmax = fmaxf(pmax, p1[r]);
  { auto rr = __builtin_amdgcn_permlane32_swap(__float_as_uint(pmax), __float_as_uint(pmax), false, false);
    pmax = fmaxf(__uint_as_float(rr[0]), __uint_as_float(rr[1])); }
  if (__builtin_expect(__all(pmax - m_reg <= THR / SCALE), 1)) { mn = m_reg; alpha = 1.f; }
  else { mn = fmaxf(m_reg, pmax); alpha = __builtin_amdgcn_exp2f((m_reg - mn) * C); m_reg = mn; }
  float mnC = -mn * C;
  for (int r = 0; r < 16; ++r) p0[r] = fmaf(p0[r], C, mnC); for (int r = 0; r < 16; ++r) p1[r] = fmaf(p1[r], C, mnC);
  for (int r = 0; r < 16; ++r) p0[r] = __builtin_amdgcn_exp2f(p0[r]);
}
__device__ __forceinline__ void finishSM(f32x16& p0, f32x16& p1, float alpha, float& l_reg, bf16x8& pa0, bf16x8& pa1, bf16x8& pa2, bf16x8& pa3) {
  for (int r = 0; r < 16; ++r) p1[r] = __builtin_amdgcn_exp2f(p1[r]);
  float ps = 0; for (int r = 0; r < 16; ++r) ps += p0[r]; for (int r = 0; r < 16; ++r) ps += p1[r];
  { auto rr = __builtin_amdgcn_permlane32_swap(__float_as_uint(ps), __float_as_uint(ps), false, false);
    ps = __uint_as_float(rr[0]) + __uint_as_float(rr[1]); }
  l_reg = l_reg * alpha + ps;
#define PK4(P, BASE, OUT) do { unsigned a0 = cvtpk(P[BASE + 0], P[BASE + 1]), a1 = cvtpk(P[BASE + 2], P[BASE + 3]);   \
    unsigned b0 = cvtpk(P[BASE + 4], P[BASE + 5]), b1 = cvtpk(P[BASE + 6], P[BASE + 7]);                              \
    auto r0 = __builtin_amdgcn_permlane32_swap(a0, b0, false, false); auto r1 = __builtin_amdgcn_permlane32_swap(a1, b1, false, false); \
    u32x4 w = {r0[0], r1[0], r0[1], r1[1]}; OUT = *reinterpret_cast<bf16x8*>(&w); } while (0)
  PK4(p0, 0, pa0); PK4(p0, 8, pa1); PK4(p1, 0, pa2); PK4(p1, 8, pa3);
#undef PK4
}
__device__ __forceinline__ void qkt(f32x16& p0, f32x16& p1, const bf16* Ks, const bf16x8* qr, int r32, int hi) {
  p0 = f32x16{}; p1 = f32x16{};
  for (int d0 = 0; d0 < 8; ++d0) { int cb = (d0 * 16 + hi * 8) * 2;
    bf16x8 b0 = *reinterpret_cast<const bf16x8*>((const char*)Ks + KSWZ(r32, cb));
    bf16x8 b1 = *reinterpret_cast<const bf16x8*>((const char*)Ks + KSWZ(32 + r32, cb));
    p0 = __builtin_amdgcn_mfma_f32_32x32x16_bf16(b0, qr[d0], p0, 0, 0, 0);
    p1 = __builtin_amdgcn_mfma_f32_32x32x16_bf16(b1, qr[d0], p1, 0, 0, 0); }
}
__device__ __forceinline__ int v_st(int k, int c) { const int kk = (k & ~0xC) | ((k & 4) << 1) | ((k & 8) >> 1); return ((kk >> 3) * 4 + (c >> 5)) * 512 + ((kk & 7) * 32 + (c & 31)) * 2; }
__device__ __forceinline__ int v_rd_base(int lane) { return ((lane & 3) << 3) | (((lane >> 2) & 3) << 6) | (((lane >> 4) & 1) << 5) | (((lane >> 5) & 1) << 8); }
constexpr int v_rd_off(int d0, int ks, int half) { return d0 * 512 + ks * 4096 + half * 2048; }
template <int OFF> __device__ __forceinline__ s16x4 tr_read(int vb) {
  s16x4 r; asm volatile("ds_read_b64_tr_b16 %0, %1 offset:%2" : "=&v"(r) : "v"(vb), "i"(OFF) : "memory"); return r;
}
template <int D0> __device__ __forceinline__ void pv_one(f32x16& od, int vb, bf16x8 pa0, bf16x8 pa1, bf16x8 pa2, bf16x8 pa3) {
  const s16x4 l0 = tr_read<v_rd_off(D0, 0, 0)>(vb), h0 = tr_read<v_rd_off(D0, 0, 1)>(vb), l1 = tr_read<v_rd_off(D0, 1, 0)>(vb), h1 = tr_read<v_rd_off(D0, 1, 1)>(vb);
  const s16x4 l2 = tr_read<v_rd_off(D0, 2, 0)>(vb), h2 = tr_read<v_rd_off(D0, 2, 1)>(vb), l3 = tr_read<v_rd_off(D0, 3, 0)>(vb), h3 = tr_read<v_rd_off(D0, 3, 1)>(vb);
  asm volatile("s_waitcnt lgkmcnt(0)" ::: "memory"); SBAR();
#define PK(L, H) (bf16x8){L[0], L[1], L[2], L[3], H[0], H[1], H[2], H[3]}
  od = __builtin_amdgcn_mfma_f32_32x32x16_bf16(pa0, PK(l0, h0), od, 0, 0, 0);
  od = __builtin_amdgcn_mfma_f32_32x32x16_bf16(pa1, PK(l1, h1), od, 0, 0, 0);
  od = __builtin_amdgcn_mfma_f32_32x32x16_bf16(pa2, PK(l2, h2), od, 0, 0, 0);
  od = __builtin_amdgcn_mfma_f32_32x32x16_bf16(pa3, PK(l3, h3), od, 0, 0, 0);
#undef PK
}
__device__ __forceinline__ void pv_d0(f32x16* o, int vb, bf16x8 pa0, bf16x8 pa1, bf16x8 pa2, bf16x8 pa3) {
  pv_one<0>(o[0], vb, pa0, pa1, pa2, pa3); pv_one<1>(o[1], vb, pa0, pa1, pa2, pa3); pv_one<2>(o[2], vb, pa0, pa1, pa2, pa3); pv_one<3>(o[3], vb, pa0, pa1, pa2, pa3);
}

__device__ __forceinline__ void attn_dense_body(const bf16* __restrict__ Qb, const bf16* __restrict__ Kh, const bf16* __restrict__ Vh,
                                                bf16* __restrict__ Ob, int seq, char* lds) {
  const int tid = threadIdx.x, wid = tid >> 6, lane = tid & 63, r32 = lane & 31, hi = lane >> 5;
  bf16* V_lds = (bf16*)lds; bf16* K_lds = (bf16*)(lds + 2 * SHM_V);
  float* ws = (float*)(lds + 2 * SHM_V + 2 * SHM_K) + wid * 64; float* li_l = ws; float* al_l = ws + 32;
  float m_reg = -1e30f, l_reg = 0; f32x16 o[4] = {}; bf16x8 qr[8];
  const bf16* Qw = Qb + (long)(wid * QBLK + r32) * LDQ + hi * 8;
#pragma unroll
  for (int d0 = 0; d0 < 8; ++d0) qr[d0] = *reinterpret_cast<const bf16x8*>(Qw + d0 * 16);
  const int sr = tid >> 4, sc = (tid & 15) * 8, vst0 = v_st(sr, sc), vst1 = v_st(32 + sr, sc);
  const int vb0 = (int)(uintptr_t)V_lds + v_rd_base(lane);
  struct { bf16x8 vs0, vs1, ks0, ks1; } sr_[SDEPTH];
#define SLOAD(i, k0) do { sr_[i].vs0 = LD8(&Vh[(long)((k0) + sr) * LDK + sc]); sr_[i].vs1 = LD8(&Vh[(long)((k0) + 32 + sr) * LDK + sc]); \
    sr_[i].ks0 = LD8(&Kh[(long)((k0) + sr) * LDK + sc]); sr_[i].ks1 = LD8(&Kh[(long)((k0) + 32 + sr) * LDK + sc]); } while (0)
#define SWRITE(b, i) do { *(bf16x8*)((char*)V_lds + (b) * SHM_V + vst0) = (sr_[i].vs0);          \
    *(bf16x8*)((char*)V_lds + (b) * SHM_V + vst1) = (sr_[i].vs1); int kc = sc * 2;               \
    *(bf16x8*)((char*)K_lds + (b) * SHM_K + KSWZ(sr, kc)) = (sr_[i].ks0);                       \
    *(bf16x8*)((char*)K_lds + (b) * SHM_K + KSWZ(32 + sr, kc)) = (sr_[i].ks1); } while (0)
#define SWAIT() do { if constexpr (SDEPTH == 2) asm volatile("s_waitcnt vmcnt(4)" ::: "memory"); else asm volatile("s_waitcnt vmcnt(0)" ::: "memory"); } while (0)
#define RESC(a) do { if (__any((a) < 1.f)) { if (hi == 0) al_l[r32] = (a); asm volatile("s_waitcnt lgkmcnt(0)" ::: "memory"); \
    for (int d = 0; d < 4; ++d) for (int r = 0; r < 16; ++r) o[d][r] *= al_l[crow(r, hi)]; } } while (0)
  f32x16 pA0, pA1, pB0, pB1; float mnA, mnB, alA, alB; bf16x8 pa0, pa1, pa2, pa3; const int NT = seq / KVBLK;
  constexpr int SE = 0, SO = SDEPTH - 1;
  SLOAD(SE, 0); asm volatile("s_waitcnt vmcnt(0)" ::: "memory"); SWRITE(0, SE); __syncthreads();
  qkt(pA0, pA1, K_lds, qr, r32, hi); partialSM(pA0, pA1, m_reg, mnA, alA);
  SLOAD(SO, KVBLK); if constexpr (SDEPTH == 2) { if (2 < NT) SLOAD(SE, 2 * KVBLK); }
  SWAIT(); SWRITE(1, SO); __syncthreads();
  for (int j = 1; j + 1 < NT; j += 2) {
    SBAR(); qkt(pB0, pB1, (bf16*)((char*)K_lds + SHM_K), qr, r32, hi);
    finishSM(pA0, pA1, alA, l_reg, pa0, pa1, pa2, pa3); SBAR();
    SLOAD(SO, (j + SDEPTH) * KVBLK); SBAR();
    pv_d0(o, vb0, pa0, pa1, pa2, pa3); partialSM(pB0, pB1, m_reg, mnB, alB);
    __syncthreads(); SWAIT(); SWRITE(0, SE);
    RESC(alB); __syncthreads();
    SBAR(); qkt(pA0, pA1, K_lds, qr, r32, hi);
    finishSM(pB0, pB1, alB, l_reg, pa0, pa1, pa2, pa3); SBAR();
    if (SDEPTH == 1 || j + 3 < NT) SLOAD(SE, (j + 1 + SDEPTH) * KVBLK); SBAR();
    pv_d0(o, vb0 + (int)SHM_V, pa0, pa1, pa2, pa3); partialSM(pA0, pA1, m_reg, mnA, alA);
    __syncthreads(); SWAIT(); SWRITE(1, SO);
    RESC(alA); __syncthreads();
  }
  SBAR(); qkt(pB0, pB1, (bf16*)((char*)K_lds + SHM_K), qr, r32, hi);
  finishSM(pA0, pA1, alA, l_reg, pa0, pa1, pa2, pa3); SBAR();
  pv_d0(o, vb0, pa0, pa1, pa2, pa3); partialSM(pB0, pB1, m_reg, mnB, alB);
  __syncthreads(); RESC(alB);
  finishSM(pB0, pB1, alB, l_reg, pa0, pa1, pa2, pa3); SBAR();
  pv_d0(o, vb0 + (int)SHM_V, pa0, pa1, pa2, pa3);
  if (hi == 0) li_l[r32] = l_reg; asm volatile("s_waitcnt lgkmcnt(0)" ::: "memory");
  float rli[16];
#pragma unroll
  for (int r = 0; r < 16; ++r) rli[r] = __builtin_amdgcn_rcpf(li_l[crow(r, hi)]);
  bf16* Ow = Ob + (long)(wid * QBLK) * LDO;
#pragma unroll
  for (int r = 0; r < 16; ++r) { int orow = crow(r, hi);
    for (int d0 = 0; d0 < 4; ++d0) Ow[(long)orow * LDO + d0 * 32 + r32] = (bf16)(cvtpk(o[d0][r] * rli[r], 0.f) & 0xffffu); }
#undef SLOAD
#undef SWRITE
#undef SWAIT
#undef RESC
}

#undef LD8
#undef KSWZ
}

constexpr int NWAVES = 8;
#ifndef MK_PER_PHASE
#define MK_PER_PHASE 0
#endif
constexpr int N_PHASES = 13;

constexpr int DM = 4096, FF = 11008, NPROJ = 9216, AW = 2048, KVW = 512, CW = 2048, HD = 128;
constexpr int M_PROMPT = 4 * 4096, M_SAMPLE = 16384, M = M_PROMPT + M_SAMPLE;
constexpr int S_PROMPT = 4096, S_SAMPLE = 16384;
constexpr int PO_Q = 0, PO_K = 2048, PO_V = 2560, PO_B = 3072, PO_C = 5120, PO_H = 7168;
constexpr float EPS = 1e-6f;

constexpr size_t MiB = 1u << 20;
constexpr size_t WS_CTL = 0, CTL_ZERO_BYTES = 64 * 1024;
constexpr size_t WS_ROPE = 1 * MiB;
constexpr size_t WS_WA = 2 * MiB;
constexpr size_t WS_WD = 174 * MiB;
constexpr size_t WS_WIN = 260 * MiB;
constexpr size_t WS_WOUT = 332 * MiB;
constexpr size_t WS_XN = 364 * MiB;
constexpr size_t WS_Y = 620 * MiB;
constexpr size_t WS_H = 876 * MiB;
constexpr size_t WS_END = 1564 * MiB;
static_assert(WS_WA + (size_t)2 * FF * DM * 2 <= WS_WD && WS_WD + (size_t)DM * FF * 2 <= WS_WIN && WS_WIN + (size_t)NPROJ * DM * 2 <= WS_WOUT && WS_WOUT + (size_t)DM * DM * 2 <= WS_XN &&
              WS_XN + (size_t)M * DM * 2 <= WS_Y && WS_Y + (size_t)M * DM * 2 <= WS_H && WS_H + (size_t)M * FF * 2 <= WS_END, "d_ws map");
constexpr int CW_BAR = 1024;
constexpr int RING_OFF = 0, RING_BYTES = 131072;
constexpr int MISC_OFF = RING_BYTES;
constexpr int LDS_BYTES = 147456;

#define GAS __attribute__((address_space(1)))
#define LAS __attribute__((address_space(3)))
typedef unsigned short bf16;
typedef unsigned v4u __attribute__((ext_vector_type(4)));
typedef unsigned v2u __attribute__((ext_vector_type(2)));
typedef float f32x4 __attribute__((ext_vector_type(4)));
typedef float f32x2 __attribute__((ext_vector_type(2)));
#define LDS_WAIT() asm volatile("s_waitcnt lgkmcnt(0)" ::: "memory")
#define VM_WAIT() asm volatile("s_waitcnt vmcnt(0)" ::: "memory")
__device__ __forceinline__ unsigned pk2(float lo, float hi) { unsigned r; asm volatile("v_cvt_pk_bf16_f32 %0, %1, %2" : "=v"(r) : "v"(lo), "v"(hi)); return r; }
__device__ __forceinline__ float bflo(unsigned w) { return __uint_as_float(w << 16); }
__device__ __forceinline__ float bfhi(unsigned w) { return __uint_as_float(w & 0xffff0000u); }
__device__ __forceinline__ float wave_sum(float v) {
#pragma unroll
    for (int o = 1; o < 64; o <<= 1) v += __shfl_xor(v, o);
    return v;
}
#define XB_TMO      128
#define XB_XCNT(j)  (256  + 64 * (j))
#define XB_XSUB(j)  (1280 + 64 * (j))
#define XB_XGEN(j)  (2304 + 64 * (j))
#define XB_TOP      3328
#define XB_TOPGEN   3392
#define XCD_BAR_WORDS 3456
#define XB_SPIN_CAP (1u << 18)

__device__ __forceinline__ unsigned xb_ld(unsigned* p)              { return __hip_atomic_load(p, __ATOMIC_RELAXED, __HIP_MEMORY_SCOPE_AGENT); }
__device__ __forceinline__ unsigned xb_add(unsigned* p, unsigned v) { return __hip_atomic_fetch_add(p, v, __ATOMIC_RELAXED, __HIP_MEMORY_SCOPE_AGENT); }
__device__ __forceinline__ unsigned xb_xcc_id() { return (unsigned)__builtin_amdgcn_s_getreg((3 << 11) | 20) & 0xFu; }
#define XB_SPIN(cond, bar) do { unsigned _sp = 0; while (cond) { __builtin_amdgcn_s_sleep(1); \
    if ((++_sp & 255u) == 0u) { if (xb_ld(&(bar)[XB_TMO])) break; if (_sp > XB_SPIN_CAP) { atomicAdd(&(bar)[XB_TMO], 1u); break; } } } } while (0)

struct XcdBarrier {
    unsigned* bar; unsigned x;
    volatile LAS unsigned* st;
};

__device__ __forceinline__ XcdBarrier xcd_barrier_post(unsigned* bar, volatile LAS unsigned* st) {
    XcdBarrier b; b.bar = bar; b.x = xb_xcc_id(); b.st = st;
    if (threadIdx.x == 0) (void)xb_add(&bar[XB_XCNT(b.x)], 1u);
    return b;
}
__device__ __forceinline__ void xcd_barrier_complete(unsigned* bar, unsigned x, unsigned& nloc, unsigned& nx) {
    const unsigned G = gridDim.x * gridDim.y * gridDim.z;
    unsigned sum, cnt, mine, sp = 0u;
    for (;;) {
        sum = 0u; cnt = 0u; mine = 0u;
#pragma unroll
        for (unsigned j = 0; j < 16; ++j) { const unsigned c = xb_ld(&bar[XB_XCNT(j)]); sum += c; cnt += (c > 0u) ? 1u : 0u; mine = (j == x) ? c : mine; }
        if (sum == G) break;
        __builtin_amdgcn_s_sleep(1);
        if ((++sp & 255u) == 0u) { if (xb_ld(&bar[XB_TMO])) break; if (sp > XB_SPIN_CAP) { atomicAdd(&bar[XB_TMO], 1u); break; } }
    }
    nloc = mine > 0u ? mine : 1u; nx = cnt > 0u ? cnt : 1u;
}

__device__ __forceinline__ void xcd_barrier(const XcdBarrier& b) {
    asm volatile("s_waitcnt vmcnt(0)" ::: "memory");
    __syncthreads();
    if (threadIdx.x == 0) {
        unsigned* bar = b.bar;
        __builtin_amdgcn_s_waitcnt(0);
        unsigned nloc = b.st[0], nx = b.st[1];
        if (nloc == 0u) { xcd_barrier_complete(bar, b.x, nloc, nx); b.st[0] = nloc; b.st[1] = nx; }
        const unsigned old = xb_add(&bar[XB_XSUB(b.x)], 1u);
        const unsigned gen = old / nloc;
        if (old + 1u == (gen + 1u) * nloc) {
            __builtin_amdgcn_fence(__ATOMIC_RELEASE, "agent");
            asm volatile("s_waitcnt vmcnt(0)" ::: "memory");
            const unsigned og = xb_add(&bar[XB_TOP], 1u);
            const unsigned tg = og / nx;
            if (og + 1u == (tg + 1u) * nx) xb_add(&bar[XB_TOPGEN], 1u);
            else XB_SPIN(xb_ld(&bar[XB_TOPGEN]) == tg, bar);
            __builtin_amdgcn_fence(__ATOMIC_ACQUIRE, "agent");
            xb_add(&bar[XB_XGEN(b.x)], 1u);
            asm volatile("s_waitcnt vmcnt(0)" ::: "memory");
        } else {
            XB_SPIN(xb_ld(&bar[XB_XGEN(b.x)]) == gen, bar);
            __builtin_amdgcn_fence(__ATOMIC_ACQUIRE, "agent");
            asm volatile("s_waitcnt vmcnt(0)" ::: "memory");
        }
    }
    __syncthreads();
}

__device__ __forceinline__ void transpose_item(const float* W, int K, int N, bf16* WT, int mode, LAS float* scr, int item, int lane) {
    const int nblk = N / 32, kb = item / nblk, nb = item % nblk, k0 = 64 * kb, n0 = 32 * nb;
    const GAS float* src = (const GAS float*)W + (size_t)k0 * N + n0 + (lane & 31);
#pragma unroll 8
    for (int i = 0; i < 32; ++i) { const int kk = 2 * i + (lane >> 5); scr[kk * 33 + (lane & 31)] = src[(size_t)kk * N]; }
    LDS_WAIT(); asm volatile("" ::: "memory");
    const int c = lane & 7;
    const int rb = (mode == 0) ? n0 : ((n0 >> 7) * 256 + (n0 & 127) + (mode == 2 ? 128 : 0));
#pragma unroll
    for (int j = 0; j < 4; ++j) { const int n = (lane >> 3) + 8 * j; const LAS float* s = scr + (8 * c) * 33 + n;
        v4u o; o.x = pk2(s[0 * 33], s[1 * 33]); o.y = pk2(s[2 * 33], s[3 * 33]); o.z = pk2(s[4 * 33], s[5 * 33]); o.w = pk2(s[6 * 33], s[7 * 33]);
        *(GAS v4u*)(WT + (size_t)(rb + n) * K + k0 + 8 * c) = o; }
    LDS_WAIT(); asm volatile("" ::: "memory");
}
constexpr int I_GU = (DM / 64) * (FF / 32), I_D = (FF / 64) * (DM / 32), I_IN = (DM / 64) * (NPROJ / 32), I_OUT = (DM / 64) * (DM / 32);
__device__ __forceinline__ void convert_ffn_item(int r, const float* Wg, const float* Wu, const float* Wd, bf16* WA, bf16* WD, LAS float* scr, int lane) {
    if (r < I_GU) { transpose_item(Wg, DM, FF, WA, 1, scr, r, lane); return; } r -= I_GU;
    if (r < I_GU) { transpose_item(Wu, DM, FF, WA, 2, scr, r, lane); return; } r -= I_GU;
    transpose_item(Wd, FF, DM, WD, 0, scr, r, lane);
}

__device__ __forceinline__ void prenorm_row(const float* xrow, const float* g, bf16* orow, int lane) {
    const GAS f32x4* xr = (const GAS f32x4*)xrow + lane; const GAS f32x4* gr = (const GAS f32x4*)g + lane;
    f32x4 v[16]; float ss = 0.f;
#pragma unroll
    for (int j = 0; j < 16; ++j) { v[j] = xr[64 * j]; ss += (v[j].x * v[j].x + v[j].y * v[j].y) + (v[j].z * v[j].z + v[j].w * v[j].w); }
    const float rinv = 1.0f / sqrtf(wave_sum(ss) * (1.f / DM) + EPS);
    GAS v2u* o8 = (GAS v2u*)orow + lane;
#pragma unroll
    for (int j = 0; j < 16; ++j) { const f32x4 gg = gr[64 * j]; v2u o; o.x = pk2(v[j].x * rinv * gg.x, v[j].y * rinv * gg.y); o.y = pk2(v[j].z * rinv * gg.z, v[j].w * rinv * gg.w); o8[64 * j] = o; }
}
__device__ __forceinline__ void resid_row(const float* xres, const bf16* yrow, const float* gpost, float s, float* outrow, const float* gpre, bf16* xnrow, int lane) {
    const GAS f32x4* xr = (const GAS f32x4*)xres + lane; const GAS v2u* yr = (const GAS v2u*)yrow + lane; const GAS f32x4* gp = (const GAS f32x4*)gpost + lane;
    f32x4 v[16]; float ss = 0.f;
#pragma unroll
    for (int j = 0; j < 16; ++j) { const v2u y = yr[64 * j]; v[j] = (f32x4){bflo(y.x), bfhi(y.x), bflo(y.y), bfhi(y.y)}; ss += (v[j].x * v[j].x + v[j].y * v[j].y) + (v[j].z * v[j].z + v[j].w * v[j].w); }
    const float ry = s / sqrtf(wave_sum(ss) * (1.f / DM) + EPS);
    GAS f32x4* orow = (GAS f32x4*)outrow + lane; float sx = 0.f;
#pragma unroll
    for (int j = 0; j < 16; ++j) { const f32x4 x = xr[64 * j], g = gp[64 * j]; v[j] = x + (v[j] * ry) * g; orow[64 * j] = v[j]; sx += (v[j].x * v[j].x + v[j].y * v[j].y) + (v[j].z * v[j].z + v[j].w * v[j].w); }
    if (gpre) {
        const float rx = 1.0f / sqrtf(wave_sum(sx) * (1.f / DM) + EPS);
        const GAS f32x4* gq = (const GAS f32x4*)gpre + lane; GAS v2u* o8 = (GAS v2u*)xnrow + lane;
#pragma unroll
        for (int j = 0; j < 16; ++j) { const f32x4 gg = gq[64 * j]; v2u o; o.x = pk2(v[j].x * rx * gg.x, v[j].y * rx * gg.y); o.y = pk2(v[j].z * rx * gg.z, v[j].w * rx * gg.w); o8[64 * j] = o; }
    }
}
__device__ __forceinline__ void unpack8(const v4u w, float (&f)[8]) { f[0] = bflo(w.x); f[1] = bfhi(w.x); f[2] = bflo(w.y); f[3] = bfhi(w.y); f[4] = bflo(w.z); f[5] = bfhi(w.z); f[6] = bflo(w.w); f[7] = bfhi(w.w); }
__device__ __forceinline__ void qk_prep_row(bf16* prow, int t, const float* qn, const float* kn, const float* rope, int lane) {
    const int hg = lane >> 3, c8 = lane & 7;
    const int pos = (c8 < 4) ? (t >> 6) : (t & 63), k0 = (c8 & 3) * 8;
    const GAS f32x4* rp = (const GAS f32x4*)(rope + (size_t)(pos * 32 + k0) * 2);
    const f32x4 r0 = rp[0], r1 = rp[1], r2 = rp[2], r3 = rp[3];
    const float cs[8] = {r0.x, r0.z, r1.x, r1.z, r2.x, r2.z, r3.x, r3.z}, sn[8] = {r0.y, r0.w, r1.y, r1.w, r2.y, r2.w, r3.y, r3.w};
#pragma unroll
    for (int p = 0; p < 3; ++p) {
        const int head = 8 * p + hg; const bool valid = head < 20; const int hc = valid ? head : 19;
        GAS v4u* hp = (GAS v4u*)(prow + hc * HD + 8 * c8);
        const v4u a = hp[0], b = hp[8];
        float x1[8], x2[8]; unpack8(a, x1); unpack8(b, x2);
        float ss = 0.f;
#pragma unroll
        for (int e = 0; e < 8; ++e) ss += x1[e] * x1[e] + x2[e] * x2[e];
        ss += __shfl_xor(ss, 1); ss += __shfl_xor(ss, 2); ss += __shfl_xor(ss, 4);
        const float rinv = 1.0f / sqrtf(ss * (1.f / HD) + EPS);
        const GAS f32x4* gp = (const GAS f32x4*)((hc < 16 ? qn : kn) + 8 * c8);
        const f32x4 ga0 = gp[0], ga1 = gp[1], gb0 = gp[16], gb1 = gp[17];
        const float g1[8] = {ga0.x, ga0.y, ga0.z, ga0.w, ga1.x, ga1.y, ga1.z, ga1.w}, g2[8] = {gb0.x, gb0.y, gb0.z, gb0.w, gb1.x, gb1.y, gb1.z, gb1.w};
        float o1[8], o2[8];
#pragma unroll
        for (int e = 0; e < 8; ++e) { const float u1 = x1[e] * rinv * g1[e], u2 = x2[e] * rinv * g2[e]; o1[e] = u1 * cs[e] - u2 * sn[e]; o2[e] = u2 * cs[e] + u1 * sn[e]; }
        if (valid) { v4u wa, wb; wa.x = pk2(o1[0], o1[1]); wa.y = pk2(o1[2], o1[3]); wa.z = pk2(o1[4], o1[5]); wa.w = pk2(o1[6], o1[7]);
            wb.x = pk2(o2[0], o2[1]); wb.y = pk2(o2[2], o2[3]); wb.z = pk2(o2[4], o2[5]); wb.w = pk2(o2[6], o2[7]); hp[0] = wa; hp[8] = wb; }
    }
}
__device__ __forceinline__ void conv_row(const bf16* prow, bool has_prev, bool has_next, const float* cw, const float* gc, bf16* aorow, int lane) {
    float y[4][8]; float ss = 0.f;
#pragma unroll
    for (int q = 0; q < 4; ++q) { const int ch = 8 * (lane + 64 * q);
        const v4u z = {0u, 0u, 0u, 0u};
        const v4u Bv = *(const GAS v4u*)(prow + PO_B + ch), Cc = *(const GAS v4u*)(prow + PO_C + ch), Hc = *(const GAS v4u*)(prow + PO_H + ch);
        const v4u Cp = has_prev ? *(const GAS v4u*)(prow - NPROJ + PO_C + ch) : z, Hp = has_prev ? *(const GAS v4u*)(prow - NPROJ + PO_H + ch) : z;
        const v4u Cn = has_next ? *(const GAS v4u*)(prow + NPROJ + PO_C + ch) : z, Hn = has_next ? *(const GAS v4u*)(prow + NPROJ + PO_H + ch) : z;
        const GAS f32x4* w = (const GAS f32x4*)(cw + ch);
        const f32x4 w0a = w[0], w0b = w[1], w1a = w[CW / 4], w1b = w[CW / 4 + 1], w2a = w[2 * CW / 4], w2b = w[2 * CW / 4 + 1];
        const float w0[8] = {w0a.x, w0a.y, w0a.z, w0a.w, w0b.x, w0b.y, w0b.z, w0b.w}, w1[8] = {w1a.x, w1a.y, w1a.z, w1a.w, w1b.x, w1b.y, w1b.z, w1b.w}, w2[8] = {w2a.x, w2a.y, w2a.z, w2a.w, w2b.x, w2b.y, w2b.z, w2b.w};
        float fb[8], fc[8], fh[8], pc[8], ph[8], nc[8], nh[8]; unpack8(Bv, fb); unpack8(Cc, fc); unpack8(Hc, fh); unpack8(Cp, pc); unpack8(Hp, ph); unpack8(Cn, nc); unpack8(Hn, nh);
#pragma unroll
        for (int e = 0; e < 8; ++e) { const float v = fb[e] * (w0[e] * (pc[e] * ph[e]) + w1[e] * (fc[e] * fh[e]) + w2[e] * (nc[e] * nh[e])); y[q][e] = v; ss += v * v; }
    }
    const float rinv = 1.0f / sqrtf(wave_sum(ss) * (1.f / CW) + EPS);
#pragma unroll
    for (int q = 0; q < 4; ++q) { const int ch = 8 * (lane + 64 * q); const GAS f32x4* g = (const GAS f32x4*)(gc + ch); const f32x4 ga = g[0], gb = g[1];
        v4u o; o.x = pk2(y[q][0] * rinv * ga.x, y[q][1] * rinv * ga.y); o.y = pk2(y[q][2] * rinv * ga.z, y[q][3] * rinv * ga.w); o.z = pk2(y[q][4] * rinv * gb.x, y[q][5] * rinv * gb.y); o.w = pk2(y[q][6] * rinv * gb.z, y[q][7] * rinv * gb.w);
        *(GAS v4u*)(aorow + AW + ch) = o; }
}
__device__ __forceinline__ void attn_norm_row(const bf16* orow, const float* ga, bf16* aorow, int lane) {
    float y[4][8]; float ss = 0.f;
#pragma unroll
    for (int q = 0; q < 4; ++q) { const v4u w = *(const GAS v4u*)(orow + 8 * (lane + 64 * q)); unpack8(w, y[q]);
#pragma unroll
        for (int e = 0; e < 8; ++e) ss += y[q][e] * y[q][e]; }
    const float rinv = 1.0f / sqrtf(wave_sum(ss) * (1.f / AW) + EPS);
#pragma unroll
    for (int q = 0; q < 4; ++q) { const int ch = 8 * (lane + 64 * q); const GAS f32x4* g = (const GAS f32x4*)(ga + ch); const f32x4 g0 = g[0], g1 = g[1];
        v4u o; o.x = pk2(y[q][0] * rinv * g0.x, y[q][1] * rinv * g0.y); o.y = pk2(y[q][2] * rinv * g0.z, y[q][3] * rinv * g0.w); o.z = pk2(y[q][4] * rinv * g1.x, y[q][5] * rinv * g1.y); o.w = pk2(y[q][6] * rinv * g1.z, y[q][7] * rinv * g1.w);
        *(GAS v4u*)(aorow + ch) = o; }
}
struct AttnUnit { int qrow0, krow0, seq, head; };
__device__ __forceinline__ bool attn_next(int G, int vcu, int i, AttnUnit& u) {
    if (G == 256) {
        if (i >= 8) return false;
        const int x = vcu >> 5, c = vcu & 31;
        if (i < 4) { const int kh = x & 3, hf = x >> 2, uu = hf * 128 + c * 4 + i, g = uu >> 6, qb = uu & 63;
            u.head = kh * 4 + g; u.krow0 = M_PROMPT; u.seq = S_SAMPLE; u.qrow0 = M_PROMPT + qb * 256; }
        else { const int j = (i - 4) >> 1, p = 2 * x + j, b = p >> 2, kh = p & 3, uu = c * 2 + ((i - 4) & 1), g = uu >> 4, qb = uu & 15;
            u.head = kh * 4 + g; u.krow0 = b * S_PROMPT; u.seq = S_PROMPT; u.qrow0 = b * S_PROMPT + qb * 256; }
        return true;
    }
    int L = i * G + vcu; if (L >= 2048) return false;
    if (L < 1024) { u.head = L >> 6; u.krow0 = M_PROMPT; u.seq = S_SAMPLE; u.qrow0 = M_PROMPT + (L & 63) * 256; }
    else { L -= 1024; const int b = L >> 8; u.head = (L >> 4) & 15; u.krow0 = b * S_PROMPT; u.seq = S_PROMPT; u.qrow0 = b * S_PROMPT + (L & 15) * 256; }
    return true;
}

struct Args { const float* in[21]; float* out; unsigned char* ws; int ph_lo, ph_hi; };
static_assert(sizeof(Args) == 21 * 8 + 8 + 8 + 8, "Args has no holes");
enum { IN_XP = 0, IN_XS, IN_F1PRE, IN_F1POST, IN_W1G, IN_W1U, IN_W1D, IN_MIXPRE, IN_MIXPOST, IN_WIN, IN_QN, IN_KN, IN_CONVW, IN_AON, IN_CON, IN_WOUT, IN_F2PRE, IN_F2POST, IN_W2G, IN_W2U, IN_W2D };

__global__ void __launch_bounds__(NWAVES * 64, 2) hymba_fwd(Args args) {
    extern __shared__ __attribute__((aligned(16))) unsigned char lds[];
    LAS unsigned char* const L = (LAS unsigned char*)lds;
    volatile LAS unsigned* const MISC = (volatile LAS unsigned*)(L + MISC_OFF);
    const int tid = threadIdx.x, lane = tid & 63, wave = __builtin_amdgcn_readfirstlane(tid >> 6);
    const int G = gridDim.x, bx = blockIdx.x, vcu = (G % 8 == 0) ? (bx % 8) * (G / 8) + bx / 8 : bx;
    const int gw = vcu * NWAVES + wave, NGW = G * NWAVES;
    unsigned char* const ws = args.ws;
    unsigned* const ctl = (unsigned*)(ws + WS_CTL);
    float* const rope = (float*)(ws + WS_ROPE);
    bf16* const WA = (bf16*)(ws + WS_WA); bf16* const WD = (bf16*)(ws + WS_WD); bf16* const WIN = (bf16*)(ws + WS_WIN); bf16* const WOUT = (bf16*)(ws + WS_WOUT);
    bf16* const XN = (bf16*)(ws + WS_XN); bf16* const Y = (bf16*)(ws + WS_Y); bf16* const H = (bf16*)(ws + WS_H); bf16* const PROJ = H; bf16* const OB = Y; bf16* const AO = XN;
    float* const out = args.out;
    for (int u = tid; u < (LDS_BYTES - MISC_OFF) / 4; u += NWAVES * 64) ((LAS unsigned*)(L + MISC_OFF))[u] = 0u;
    __syncthreads();
#if MK_PER_PHASE
#define GRID_BAR() do { } while (0)
#else
    XcdBarrier bar = xcd_barrier_post(ctl + CW_BAR, MISC + 8);
#define GRID_BAR() xcd_barrier(bar)
#endif
    const int lo = args.ph_lo, hi = args.ph_hi;
#define IN(k) (lo <= (k) && (k) < hi)
#define XROW(m) ((m) < M_PROMPT ? args.in[IN_XP] + (size_t)(m) * DM : args.in[IN_XS] + (size_t)((m) - M_PROMPT) * DM)
    LAS float* const scr = (LAS float*)(L + RING_OFF + wave * 16384);

    if (IN(0)) {
        constexpr int NITEMS = 3 * I_GU + I_IN + I_OUT;
        for (int it = gw; it < NITEMS; it += NGW) {
            int r = it;
            if (r < 3 * I_GU) { convert_ffn_item(r, args.in[IN_W1G], args.in[IN_W1U], args.in[IN_W1D], WA, WD, scr, lane); continue; } r -= 3 * I_GU;
            if (r < I_IN) { transpose_item(args.in[IN_WIN], DM, NPROJ, WIN, 0, scr, r, lane); continue; } r -= I_IN;
            transpose_item(args.in[IN_WOUT], DM, DM, WOUT, 0, scr, r, lane);
        }
        for (int idx = bx * (NWAVES * 64) + tid; idx < 256 * 32; idx += G * NWAVES * 64) {
            const int pos = idx >> 5, k = idx & 31; const float inv = exp2f(-(float)k * (13.287712379549449f / 32.f)), ang = (float)pos * inv;
            rope[2 * idx] = cosf(ang); rope[2 * idx + 1] = sinf(ang); }
        for (int m = gw; m < M; m += NGW) prenorm_row(XROW(m), args.in[IN_F1PRE], XN + (size_t)m * DM, lane);
        GRID_BAR();
    }
    if (IN(1)) {
        pg8::Gemm g{XN, WA, M, 2 * FF, DM}; pg8::StaticOrder S; S.init(M, 2 * FF, G, bx);
        pg8::EpiSwiGLU E{H, FF};
        pg8::gemm_phase<pg8::EpiSwiGLU, pg8::StaticOrder, true, true>(L + RING_OFF, g, S, E);
        GRID_BAR();
    }
    if (IN(2)) {
        pg8::Gemm g{H, WD, M, DM, FF}; pg8::StaticOrder S; S.init(M, DM, G, bx);
        pg8::EpiBf16 E{Y, DM};
        pg8::gemm_phase<pg8::EpiBf16, pg8::StaticOrder, true, true>(L + RING_OFF, g, S, E);
        GRID_BAR();
    }
    if (IN(3)) {
        for (int m = gw; m < M; m += NGW) resid_row(XROW(m), Y + (size_t)m * DM, args.in[IN_F1POST], 0.5f, out + (size_t)m * DM, args.in[IN_MIXPRE], XN + (size_t)m * DM, lane);
        for (int it = gw; it < 3 * I_GU; it += NGW) convert_ffn_item(it, args.in[IN_W2G], args.in[IN_W2U], args.in[IN_W2D], WA, WD, scr, lane);
        GRID_BAR();
    }
    if (IN(4)) {
        pg8::Gemm g{XN, WIN, M, NPROJ, DM}; pg8::StaticOrder S; S.init(M, NPROJ, G, bx);
        pg8::EpiBf16 E{PROJ, NPROJ};
        pg8::gemm_phase<pg8::EpiBf16, pg8::StaticOrder, true, true>(L + RING_OFF, g, S, E);
        GRID_BAR();
    }
    if (IN(5)) {
        for (int m = gw; m < M; m += NGW) {
            const int t = m < M_PROMPT ? (m & (S_PROMPT - 1)) : m - M_PROMPT, S = m < M_PROMPT ? S_PROMPT : S_SAMPLE;
            conv_row(PROJ + (size_t)m * NPROJ, t > 0, t < S - 1, args.in[IN_CONVW], args.in[IN_CON], AO + (size_t)m * DM, lane);
        }
        VM_WAIT(); __syncthreads();
        for (int m = gw; m < M; m += NGW) {
            const int t = m < M_PROMPT ? (m & (S_PROMPT - 1)) : m - M_PROMPT;
            qk_prep_row(PROJ + (size_t)m * NPROJ, t, args.in[IN_QN], args.in[IN_KN], rope, lane);
        }
        GRID_BAR();
    }
    if (IN(6)) {
        AttnUnit u;
        for (int i = 0; attn_next(G, vcu, i, u); ++i) {
            const int kvh = u.head >> 2;
            attn::attn_dense_body(PROJ + (size_t)u.qrow0 * NPROJ + PO_Q + u.head * HD, PROJ + (size_t)u.krow0 * NPROJ + PO_K + kvh * HD, PROJ + (size_t)u.krow0 * NPROJ + PO_V + kvh * HD,
                                  OB + (size_t)u.qrow0 * AW + u.head * HD, u.seq, (char*)lds + RING_OFF);
            __syncthreads();
        }
        GRID_BAR();
    }
    if (IN(7)) {
        for (int m = gw; m < M; m += NGW) attn_norm_row(OB + (size_t)m * AW, args.in[IN_AON], AO + (size_t)m * DM, lane);
        GRID_BAR();
    }
    if (IN(8)) {
        pg8::Gemm g{AO, WOUT, M, DM, DM}; pg8::StaticOrder S; S.init(M, DM, G, bx);
        pg8::EpiBf16 E{Y, DM};
        pg8::gemm_phase<pg8::EpiBf16, pg8::StaticOrder, true, true>(L + RING_OFF, g, S, E);
        GRID_BAR();
    }
    if (IN(9)) {
        for (int m = gw; m < M; m += NGW) resid_row(out + (size_t)m * DM, Y + (size_t)m * DM, args.in[IN_MIXPOST], 1.0f, out + (size_t)m * DM, args.in[IN_F2PRE], XN + (size_t)m * DM, lane);
        GRID_BAR();
    }
    if (IN(10)) {
        pg8::Gemm g{XN, WA, M, 2 * FF, DM}; pg8::StaticOrder S; S.init(M, 2 * FF, G, bx);
        pg8::EpiSwiGLU E{H, FF};
        pg8::gemm_phase<pg8::EpiSwiGLU, pg8::StaticOrder, true, true>(L + RING_OFF, g, S, E);
        GRID_BAR();
    }
    if (IN(11)) {
        pg8::Gemm g{H, WD, M, DM, FF}; pg8::StaticOrder S; S.init(M, DM, G, bx);
        pg8::EpiBf16 E{Y, DM};
        pg8::gemm_phase<pg8::EpiBf16, pg8::StaticOrder, true, true>(L + RING_OFF, g, S, E);
        GRID_BAR();
    }
    if (IN(12)) {
        for (int m = gw; m < M; m += NGW) resid_row(out + (size_t)m * DM, Y + (size_t)m * DM, args.in[IN_F2POST], 0.5f, out + (size_t)m * DM, nullptr, nullptr, lane);
    }
#undef IN
#undef XROW
#undef GRID_BAR
}

extern "C" void kernel_launch(void* const* d_in, const int* in_sizes, int n_in, void* d_out, int out_size, void* d_ws, size_t ws_size, hipStream_t stream) {
    static int grid = 0;
    if (grid == 0) {
        if (n_in != 21 || in_sizes[0] != M_PROMPT * DM || in_sizes[1] != M_SAMPLE * DM || out_size != M * DM || ws_size < WS_END) {
            fprintf(stderr, "kernel_launch: shape mismatch (n_in %d, out %d, ws %zu < %zu?); nothing launched\n", n_in, out_size, ws_size, (size_t)WS_END); grid = -1; return; }
        int dev = 0, cus = 0;
        if (hipGetDevice(&dev) != hipSuccess || hipDeviceGetAttribute(&cus, hipDeviceAttributeMultiprocessorCount, dev) != hipSuccess) { grid = -1; return; }
        if (hipFuncSetAttribute((const void*)hymba_fwd, hipFuncAttributeMaxDynamicSharedMemorySize, LDS_BYTES) != hipSuccess) { fprintf(stderr, "kernel_launch: hipFuncSetAttribute failed\n"); grid = -1; return; }
        int per_cu = 0;
        if (hipOccupancyMaxActiveBlocksPerMultiprocessor(&per_cu, (const void*)hymba_fwd, NWAVES * 64, LDS_BYTES) != hipSuccess || per_cu < 1)
            fprintf(stderr, "kernel_launch: note: occupancy query reports %d workgroups per CU\n", per_cu);
        (void)hipGetLastError();
        grid = cus;
    }
    if (grid < 0) return;
    if (hipMemsetAsync((char*)d_ws + WS_CTL, 0, CTL_ZERO_BYTES, stream) != hipSuccess) return;
    Args a{};
    for (int i = 0; i < 21; ++i) a.in[i] = (const float*)d_in[i];
    a.out = (float*)d_out; a.ws = (unsigned char*)d_ws;
#if MK_PER_PHASE
    for (int p = 0; p < N_PHASES; ++p) { a.ph_lo = p; a.ph_hi = p + 1; hipLaunchKernelGGL(hymba_fwd, dim3(grid), dim3(NWAVES * 64), LDS_BYTES, stream, a); }
#else
    a.ph_lo = 0; a.ph_hi = N_PHASES;
    hipLaunchKernelGGL(hymba_fwd, dim3(grid), dim3(NWAVES * 64), LDS_BYTES, stream, a);
#endif
    const hipError_t le = hipPeekAtLastError();
    if (le != hipSuccess) fprintf(stderr, "kernel_launch: launch failed: %s\n", hipGetErrorName(le));
}
```

```cpp
#include <hip/hip_runtime.h>
#include <cstdio>
#include <cstdint>
namespace pg8 {
#define PG8_LAS __attribute__((address_space(3)))
typedef unsigned short bf16_t;
typedef short bf16x8 __attribute__((ext_vector_type(8)));
typedef float f32x4 __attribute__((ext_vector_type(4)));
typedef unsigned u32x4 __attribute__((ext_vector_type(4)));
constexpr int BM = 256, BK = 64, HALF = 128, HTB = HALF * BK * 2  , STAGE_BYTES = 8 * HTB, NXCD = 8, WGM = 8;

__host__ __device__ __forceinline__ int lds_byte(int r, int c) { const int st = (r >> 4) * 2 + (c >> 5), rr = r & 15, cc = c & 31, ob = rr * 64 + cc * 2; return st * 1024 + (ob ^ (((ob >> 9) & 1) << 5)); }
__host__ __device__ __forceinline__ void stage_rc(int b, int& R, int& C) { const int st = b / 1024, sb = b % 1024, swz = sb ^ (((sb >> 9) & 1) << 5); R = (st >> 1) * 16 + swz / 64; C = (st & 1) * 32 + (swz % 64) / 2; }
__host__ __device__ __forceinline__ int perm32(int rho) { const int n = rho >> 4, i = rho & 15; return 8 * (i >> 2) + 4 * n + (i & 3); }

struct Unit { int pm, pn; };
struct Gemm { const bf16_t* A; const bf16_t* Bt; int M, N, K; };

struct StaticOrder {
    int nM, nN, nwg, G, c, wgm;
    __host__ __device__ void init(int M, int N, int G_, int c_, int wgm_ = WGM) { nM = M / BM; nN = N / BM; nwg = nM * nN; G = G_; c = c_; wgm = wgm_; }
    __host__ __device__ bool next(int i, Unit& u) const {
        const long L = (long)i * G + c; if (L >= nwg) return false;
        int wgid = (int)L; { const int q = nwg / NXCD, r = nwg % NXCD, xcd = wgid % NXCD, off = wgid / NXCD; wgid = (xcd < r ? xcd * (q + 1) : r * (q + 1) + (xcd - r) * q) + off; }
        const int nig = wgm * nN, gid = wgid / nig, fm = gid * wgm, gsz = (nM - fm) < wgm ? (nM - fm) : wgm;
        u.pm = fm + ((wgid % nig) % gsz); u.pn = (wgid % nig) / gsz; return true;
    }
    __device__ __forceinline__ void a_ready(const Unit&) const {}
    __device__ __forceinline__ void done(const Unit&) const {}
};
struct BlockOrder : StaticOrder {
    __host__ __device__ bool next(int i, Unit& u) const {
        if (G != 256 || nM != 128 || (nN & 1)) return StaticOrder::next(i, u);
        const int x = c & 7, l = c >> 3, nb16 = nN >> 4, nmain = 8 * nb16;
        if (i < nmain) { const int band = i / nb16, cb = i - band * nb16; u.pm = 16 * band + 4 * (x >> 1) + (l & 3); u.pn = 16 * cb + 8 * (x & 1) + (l >> 2); return true; }
        int r = i - nmain, c0 = nb16 * 16, rem = nN - c0;
        if (rem >= 8) { if (r < 4) { u.pm = 32 * r + 8 * (x >> 1) + (l & 7); u.pn = c0 + 4 * (x & 1) + (l >> 3); return true; } r -= 4; c0 += 8; rem -= 8; }
        if (rem >= 4) { if (r < 2) { u.pm = 64 * r + 8 * x + (l & 7); u.pn = c0 + (l >> 3); return true; } r -= 2; c0 += 4; rem -= 4; }
        if (rem >= 2) { if (r < 1) { u.pm = 16 * x + (l & 15); u.pn = c0 + (l >> 4); return true; } }
        return false;
    }
};

typedef int v8i32 __attribute__((ext_vector_type(8)));
typedef int v4i32 __attribute__((ext_vector_type(4)));
__device__ __forceinline__ v8i32 cat8(bf16x8 lo, bf16x8 hi) { return __builtin_bit_cast(v8i32, __builtin_shufflevector(lo, hi, 0, 1, 2, 3, 4, 5, 6, 7, 8, 9, 10, 11, 12, 13, 14, 15)); }
__device__ __forceinline__ unsigned pk4_fp8(float a, float b, float c, float d) { int w = 0; w = __builtin_amdgcn_cvt_pk_fp8_f32(a, b, w, false); w = __builtin_amdgcn_cvt_pk_fp8_f32(c, d, w, true); return (unsigned)w; }
__device__ __forceinline__ unsigned cvt_pk_bf16(float lo, float hi) { unsigned r; asm volatile("v_cvt_pk_bf16_f32 %0, %1, %2" : "=v"(r) : "v"(lo), "v"(hi)); return r; }

template <bool I8> struct EpiBf16T {
    static constexpr bool PERM = true, AFTER_DRAIN = false;
    bf16_t* O; int ldc; const float* rs; float cs; const float* cw;
    __device__ __forceinline__ void operator()(const f32x4 (&acc)[2][2][4][2], const Unit& u, int wr, int wc, int fr, int fq) const {
        const int row0 = u.pm * BM + wr * 64 + fr, col0 = u.pn * BM + wc * 32 + 8 * fq;
        f32x4 wv[2][2];
        if constexpr (I8) {
#pragma unroll
            for (int bj = 0; bj < 2; ++bj) { wv[bj][0] = *(const f32x4*)(cw + col0 + bj * HALF); wv[bj][1] = *(const f32x4*)(cw + col0 + bj * HALF + 4); } }
#pragma unroll
        for (int ai = 0; ai < 2; ++ai)
#pragma unroll
            for (int m = 0; m < 4; ++m) { const int row = row0 + ai * HALF + m * 16; bf16_t* rowp = O + (size_t)row * ldc + col0; const float sc = rs ? rs[row] * cs : cs;
#pragma unroll
                for (int bj = 0; bj < 2; ++bj) { f32x4 v0, v1;
                    if constexpr (I8) { v0 = __builtin_convertvector(__builtin_bit_cast(v4i32, acc[ai][bj][m][0]), f32x4) * wv[bj][0] * sc; v1 = __builtin_convertvector(__builtin_bit_cast(v4i32, acc[ai][bj][m][1]), f32x4) * wv[bj][1] * sc; }
                    else { v0 = acc[ai][bj][m][0] * sc; v1 = acc[ai][bj][m][1] * sc; }
                    u32x4 w; w.x = cvt_pk_bf16(v0[0], v0[1]); w.y = cvt_pk_bf16(v0[2], v0[3]); w.z = cvt_pk_bf16(v1[0], v1[1]); w.w = cvt_pk_bf16(v1[2], v1[3]);
                    *(u32x4*)(rowp + bj * HALF) = w; } }
    }
};
typedef EpiBf16T<false> EpiBf16;
__device__ __forceinline__ float silu_mul(float g, float u) { return g * u * __builtin_amdgcn_rcpf(1.0f + __builtin_amdgcn_exp2f(-1.4426950408889634f * g)); }
__device__ __forceinline__ unsigned cvt_pk_f16(float lo, float hi) { return __builtin_bit_cast(unsigned, __builtin_amdgcn_cvt_pkrtz(lo, hi)); }
template <bool F8  , bool I8 = false  , bool H16 = false  > struct EpiSwiGLU {
    static constexpr bool PERM = true, AFTER_DRAIN = false;
    bf16_t* O; int ldc; const float* rs; const float* cw; int cup;
    __device__ __forceinline__ void operator()(const f32x4 (&acc)[2][2][4][2], const Unit& u, int wr, int wc, int fr, int fq) const {
        const int row0 = u.pm * BM + wr * 64 + fr, col0 = u.pn * HALF + wc * 32 + 8 * fq;
        f32x4 wg0 = {1.f, 1.f, 1.f, 1.f}, wg1 = wg0, wu0 = wg0, wu1 = wg0;
        if constexpr (I8) { const float k = 1.0f / 127.0f; wg0 = *(const f32x4*)(cw + col0) * k; wg1 = *(const f32x4*)(cw + col0 + 4) * k; wu0 = *(const f32x4*)(cw + cup + col0) * k; wu1 = *(const f32x4*)(cw + cup + col0 + 4) * k; }
#pragma unroll
        for (int ai = 0; ai < 2; ++ai)
#pragma unroll
            for (int m = 0; m < 4; ++m) { const int row = row0 + ai * HALF + m * 16; const float sc = rs[row];
                f32x4 g0, g1, u0, u1;
                if constexpr (I8) { const v4i32 ig0 = __builtin_bit_cast(v4i32, acc[ai][0][m][0]), ig1 = __builtin_bit_cast(v4i32, acc[ai][0][m][1]), iu0 = __builtin_bit_cast(v4i32, acc[ai][1][m][0]), iu1 = __builtin_bit_cast(v4i32, acc[ai][1][m][1]);
                    g0 = __builtin_convertvector(ig0, f32x4) * wg0 * sc; g1 = __builtin_convertvector(ig1, f32x4) * wg1 * sc; u0 = __builtin_convertvector(iu0, f32x4) * wu0 * sc; u1 = __builtin_convertvector(iu1, f32x4) * wu1 * sc; }
                else { g0 = acc[ai][0][m][0] * sc; g1 = acc[ai][0][m][1] * sc; u0 = acc[ai][1][m][0] * sc; u1 = acc[ai][1][m][1] * sc; }
                if constexpr (F8) { typedef unsigned u32x2 __attribute__((ext_vector_type(2))); u32x2 w8;
                    w8.x = pk4_fp8(silu_mul(g0[0], u0[0]), silu_mul(g0[1], u0[1]), silu_mul(g0[2], u0[2]), silu_mul(g0[3], u0[3]));
                    w8.y = pk4_fp8(silu_mul(g1[0], u1[0]), silu_mul(g1[1], u1[1]), silu_mul(g1[2], u1[2]), silu_mul(g1[3], u1[3]));
                    *(u32x2*)((unsigned char*)O + (size_t)row * ldc + col0) = w8; continue; }
                bf16_t* rowp = O + (size_t)row * ldc + col0;
                u32x4 w;
                if constexpr (H16) { w.x = cvt_pk_f16(silu_mul(g0[0], u0[0]), silu_mul(g0[1], u0[1])); w.y = cvt_pk_f16(silu_mul(g0[2], u0[2]), silu_mul(g0[3], u0[3]));
                    w.z = cvt_pk_f16(silu_mul(g1[0], u1[0]), silu_mul(g1[1], u1[1])); w.w = cvt_pk_f16(silu_mul(g1[2], u1[2]), silu_mul(g1[3], u1[3])); }
                else { w.x = cvt_pk_bf16(silu_mul(g0[0], u0[0]), silu_mul(g0[1], u0[1])); w.y = cvt_pk_bf16(silu_mul(g0[2], u0[2]), silu_mul(g0[3], u0[3]));
                    w.z = cvt_pk_bf16(silu_mul(g1[0], u1[0]), silu_mul(g1[1], u1[1])); w.w = cvt_pk_bf16(silu_mul(g1[2], u1[2]), silu_mul(g1[3], u1[3])); }
#ifdef NT_H
                __builtin_nontemporal_store(w, (u32x4*)rowp); }
#else
                *(u32x4*)rowp = w; }
#endif
    }
};

template <class Epi, class Sched, bool ALIGN_EPI = false, bool SP2 = false, int MM = 0>
__device__ __forceinline__ void gemm_phase(PG8_LAS unsigned char* lds, const Gemm g, const Sched& S, const Epi& E) {
    const int tid = threadIdx.x, wid = __builtin_amdgcn_readfirstlane(tid >> 6), lane = tid & 63, wr = wid >> 2, wc = wid & 3, fr = lane & 15, fq = lane >> 4;
    const int K = g.K, nt = K / BK;
    unsigned voffA[2], voffB[2];
#pragma unroll
    for (int i = 0; i < 2; ++i) { int R, C; stage_rc(tid * 16 + i * 8192, R, C); const int Rb = Epi::PERM ? ((R & ~31) + perm32(R & 31)) : R;
        voffA[i] = (unsigned)(R * K + C) * 2u; voffB[i] = (unsigned)(Rb * K + C) * 2u; }
    const size_t kstep = (size_t)(BK * 2);
    const size_t hstep = (size_t)HALF * K * 2;
    const size_t tstep = 2 * hstep;
    const unsigned ldsw = (unsigned)wid * 1024u;
    const int aoff = lds_byte(wr * 64 + fr, fq * 8), boff = lds_byte(wc * 32 + fr, fq * 8);
#define PG8_SA(b, h) (((b) * 2 + (h)) * HTB)
#define PG8_SB(b, h) ((4 + (b) * 2 + (h)) * HTB)
#define PG8_STAGE(bufoff, gbase, voff) do { _Pragma("unroll") for (int _i = 0; _i < 2; ++_i) \
        __builtin_amdgcn_global_load_lds((const unsigned*)((const char*)(gbase) + (voff)[_i]), (PG8_LAS unsigned*)(lds + (bufoff) + ldsw + _i * 8192), 16, 0, 0); } while (0)
#define PG8_LDA(dst, b, h) do { _Pragma("unroll") for (int m = 0; m < 4; ++m) { if constexpr (MM == 1) dst##8[m] = cat8(*(const PG8_LAS bf16x8*)(lds + PG8_SA(b, h) + aoff + m * 2048), *(const PG8_LAS bf16x8*)(lds + PG8_SA(b, h) + aoff + m * 2048 + 1024)); \
        else { _Pragma("unroll") for (int k = 0; k < 2; ++k) dst[m][k] = *(const PG8_LAS bf16x8*)(lds + PG8_SA(b, h) + aoff + m * 2048 + k * 1024); } } } while (0)
#define PG8_LDB(dst, b, h) do { _Pragma("unroll") for (int n = 0; n < 2; ++n) { if constexpr (MM == 1) dst##8[n] = cat8(*(const PG8_LAS bf16x8*)(lds + PG8_SB(b, h) + boff + n * 2048), *(const PG8_LAS bf16x8*)(lds + PG8_SB(b, h) + boff + n * 2048 + 1024)); \
        else { _Pragma("unroll") for (int k = 0; k < 2; ++k) dst[n][k] = *(const PG8_LAS bf16x8*)(lds + PG8_SB(b, h) + boff + n * 2048 + k * 1024); } } } while (0)
#define PG8_MMA(ai, bj, At, Bt) do { __builtin_amdgcn_s_setprio(1); _Pragma("unroll") for (int m = 0; m < 4; ++m) _Pragma("unroll") for (int n = 0; n < 2; ++n) { \
        if constexpr (MM == 1) asm volatile("v_mfma_scale_f32_16x16x128_f8f6f4 %0, %1, %2, %0, %3, %3 op_sel_hi:[0,0,0]" : "+v"(acc[ai][bj][m][n]) : "v"(Bt##8[n]), "v"(At##8[m]), "v"(sc127));   \
        else if constexpr (MM == 2) { _Pragma("unroll") for (int k = 0; k < 2; ++k) acc[ai][bj][m][n] = __builtin_bit_cast(f32x4, __builtin_amdgcn_mfma_i32_16x16x64_i8(__builtin_bit_cast(v4i32, Bt[n][k]), __builtin_bit_cast(v4i32, At[m][k]), __builtin_bit_cast(v4i32, acc[ai][bj][m][n]), 0, 0, 0)); } \
        else { _Pragma("unroll") for (int k = 0; k < 2; ++k) acc[ai][bj][m][n] = __builtin_amdgcn_mfma_f32_16x16x32_bf16(Bt[n][k], At[m][k], acc[ai][bj][m][n], 0, 0, 0); } } \
        __builtin_amdgcn_s_setprio(0); } while (0)
#define PG8_WAIT_V(n) asm volatile("s_waitcnt vmcnt(" #n ")" ::: "memory")
#define PG8_WAIT_L(n) asm volatile("s_waitcnt lgkmcnt(" #n ")" ::: "memory")
#define PG8_BAR __builtin_amdgcn_s_barrier()
#define PG8_SCHED __builtin_amdgcn_sched_barrier(0)
    Unit cur, nxt; int ui = 0;
    if (!S.next(0, cur)) return;
    f32x4 acc[2][2][4][2];
#pragma unroll
    for (int a = 0; a < 2; ++a)
#pragma unroll
        for (int b = 0; b < 2; ++b)
#pragma unroll
            for (int m = 0; m < 4; ++m)
#pragma unroll
                for (int n = 0; n < 2; ++n) acc[a][b][m][n] = (f32x4){0.f, 0.f, 0.f, 0.f};
    bf16x8 At[4][2], B0[2][2], B1[2][2]; v8i32 At8[4], B08[2], B18[2]; const int sc127 = 0x7F7F7F7F;
    const char* cA = (const char*)g.A + (size_t)cur.pm * tstep; const char* cB = (const char*)g.Bt + (size_t)cur.pn * tstep;
    S.a_ready(cur);
    if constexpr (SP2) {
        PG8_STAGE(PG8_SB(0, 0), cB, voffB); PG8_STAGE(PG8_SB(0, 1), cB + hstep, voffB); PG8_STAGE(PG8_SA(0, 0), cA, voffA); PG8_STAGE(PG8_SA(0, 1), cA + hstep, voffA);
        if (wr == 1) PG8_BAR;
        PG8_WAIT_V(2); PG8_BAR;
        PG8_STAGE(PG8_SB(1, 0), cB + kstep, voffB); PG8_STAGE(PG8_SA(1, 0), cA + kstep, voffA); PG8_STAGE(PG8_SB(1, 1), cB + hstep + kstep, voffB);
        PG8_WAIT_V(6); PG8_BAR;
    } else {
        PG8_STAGE(PG8_SB(0, 0), cB, voffB); PG8_STAGE(PG8_SA(0, 0), cA, voffA); PG8_STAGE(PG8_SB(0, 1), cB + hstep, voffB); PG8_STAGE(PG8_SA(0, 1), cA + hstep, voffA);
        if (wr == 1) PG8_BAR;
        PG8_WAIT_V(4); PG8_BAR;
        PG8_STAGE(PG8_SB(1, 0), cB + kstep, voffB); PG8_STAGE(PG8_SA(1, 0), cA + kstep, voffA); PG8_STAGE(PG8_SB(1, 1), cB + hstep + kstep, voffB);
        PG8_WAIT_V(6); PG8_BAR;
    }
    for (;;) {
        const bool has_next = S.next(ui + 1, nxt);
        const char* nA = has_next ? (const char*)g.A + (size_t)nxt.pm * tstep : cA; const char* nB = has_next ? (const char*)g.Bt + (size_t)nxt.pn * tstep : cB;
        for (int t = 0; t < nt; t += 2) {
            const bool last = (t == nt - 2);
            const char* a1 = cA + (size_t)(t + 1) * kstep;
            const char* a2 = last ? nA : cA + (size_t)(t + 2) * kstep; const char* b2 = last ? nB : cB + (size_t)(t + 2) * kstep;
            const char* a3 = a2 + kstep; const char* b3 = b2 + kstep;
            if (last && has_next) S.a_ready(nxt);
            if constexpr (SP2) {
            PG8_LDB(B0, 0, 0); PG8_LDB(B1, 0, 1); PG8_SCHED; PG8_LDA(At, 0, 0); PG8_STAGE(PG8_SA(1, 1), a1 + hstep, voffA);
            PG8_WAIT_V(8); PG8_WAIT_L(0); PG8_BAR; PG8_MMA(0, 0, At, B0); PG8_MMA(0, 1, At, B1); PG8_BAR; PG8_SCHED;
            PG8_LDA(At, 0, 1); PG8_STAGE(PG8_SB(0, 0), b2, voffB); PG8_STAGE(PG8_SB(0, 1), b2 + hstep, voffB); PG8_STAGE(PG8_SA(0, 0), a2, voffA);
            PG8_WAIT_V(8); PG8_WAIT_L(0); PG8_BAR; PG8_MMA(1, 0, At, B0); PG8_MMA(1, 1, At, B1); PG8_BAR; PG8_SCHED;
            PG8_LDB(B0, 1, 0); PG8_LDB(B1, 1, 1); PG8_SCHED; PG8_LDA(At, 1, 0); PG8_STAGE(PG8_SA(0, 1), a2 + hstep, voffA);
            PG8_WAIT_V(8); PG8_WAIT_L(0); PG8_BAR; PG8_MMA(0, 0, At, B0); PG8_MMA(0, 1, At, B1); PG8_BAR; PG8_SCHED;
            PG8_LDA(At, 1, 1); PG8_STAGE(PG8_SB(1, 0), b3, voffB); PG8_STAGE(PG8_SB(1, 1), b3 + hstep, voffB); PG8_STAGE(PG8_SA(1, 0), a3, voffA);
            PG8_WAIT_V(8); PG8_WAIT_L(0); PG8_BAR; PG8_MMA(1, 0, At, B0); PG8_MMA(1, 1, At, B1); PG8_BAR; PG8_SCHED;
            } else {
            PG8_LDB(B0, 0, 0); PG8_SCHED; PG8_LDA(At, 0, 0); PG8_STAGE(PG8_SA(1, 1), a1 + hstep, voffA);
            PG8_WAIT_L(8); PG8_BAR; PG8_WAIT_L(0); PG8_MMA(0, 0, At, B0); PG8_BAR; PG8_SCHED;
            PG8_LDB(B1, 0, 1); PG8_STAGE(PG8_SB(0, 0), b2, voffB);
            PG8_BAR; PG8_WAIT_L(0); PG8_MMA(0, 1, At, B1); PG8_BAR;
            PG8_LDA(At, 0, 1); PG8_STAGE(PG8_SA(0, 0), a2, voffA);
            PG8_BAR; PG8_WAIT_L(0); PG8_MMA(1, 0, At, B0); PG8_BAR; PG8_SCHED;
            PG8_STAGE(PG8_SB(0, 1), b2 + hstep, voffB);
            PG8_WAIT_V(6); PG8_BAR; PG8_MMA(1, 1, At, B1); PG8_BAR;
            PG8_LDB(B0, 1, 0); PG8_SCHED; PG8_LDA(At, 1, 0); PG8_STAGE(PG8_SA(0, 1), a2 + hstep, voffA);
            PG8_WAIT_L(8); PG8_BAR; PG8_WAIT_L(0); PG8_MMA(0, 0, At, B0); PG8_BAR; PG8_SCHED;
            PG8_LDB(B1, 1, 1); PG8_STAGE(PG8_SB(1, 0), b3, voffB);
            PG8_BAR; PG8_WAIT_L(0); PG8_MMA(0, 1, At, B1); PG8_BAR;
            PG8_LDA(At, 1, 1); PG8_STAGE(PG8_SA(1, 0), a3, voffA);
            PG8_BAR; PG8_WAIT_L(0); PG8_MMA(1, 0, At, B0); PG8_BAR; PG8_SCHED;
            PG8_STAGE(PG8_SB(1, 1), b3 + hstep, voffB);
            PG8_WAIT_V(6); PG8_BAR; PG8_MMA(1, 1, At, B1); PG8_BAR;
            }
        }
        if constexpr (MM == 1) asm volatile("s_nop 15\n\ts_nop 15" ::: "memory");
        if constexpr (ALIGN_EPI) { if (wr == 0) PG8_BAR; }
        if constexpr (!Epi::AFTER_DRAIN) { E(acc, cur, wr, wc, fr, fq); S.done(cur); }
        if (!has_next) break;
#pragma unroll
        for (int a = 0; a < 2; ++a)
#pragma unroll
            for (int b = 0; b < 2; ++b)
#pragma unroll
                for (int m = 0; m < 4; ++m)
#pragma unroll
                    for (int n = 0; n < 2; ++n) acc[a][b][m][n] = (f32x4){0.f, 0.f, 0.f, 0.f};
        cur = nxt; cA = nA; cB = nB; ++ui;
        if constexpr (ALIGN_EPI) { if (wr == 1) PG8_BAR; }
    }
    PG8_WAIT_V(0);
    if constexpr (!ALIGN_EPI) { if (wr == 0) PG8_BAR; }
    PG8_BAR;
    if constexpr (Epi::AFTER_DRAIN) { E.fused(acc, cur, wr, wc, fr, fq, lds, wid, lane); S.done(cur); }
#undef PG8_SA
#undef PG8_SB
#undef PG8_STAGE
#undef PG8_LDA
#undef PG8_LDB
#undef PG8_MMA
#undef PG8_WAIT_V
#undef PG8_WAIT_L
#undef PG8_BAR
#undef PG8_SCHED
}
}
namespace attn {
using bf16 = unsigned short;
constexpr int   D = 128, NW = 8, QBLK = 32, KVBLK = 64;
constexpr float SCALE = 0.088388347648318440f;
constexpr float THR = 8.f;
#ifndef ATTN_QPRE
#define ATTN_QPRE 1
#endif
constexpr bool QPRE = ATTN_QPRE != 0;
constexpr float QC = SCALE * 1.4426950408889634f;
constexpr int SDEPTH = 2;
#ifndef KSWZ_MASK
#define KSWZ_MASK 15
#endif
constexpr int LDQ = 9216, LDK = 128, LDO = 2048;
constexpr size_t SHM_V = KVBLK * D * 2, SHM_K = KVBLK * D * 2, SHM_ATTN = 2 * SHM_V + 2 * SHM_K + NW * 64 * 4;
#define LD8(p) (*reinterpret_cast<const bf16x8*>(p))
using bf16x8 = __attribute__((ext_vector_type(8))) short;
using s16x4  = __attribute__((ext_vector_type(4))) short;
using f32x16 = __attribute__((ext_vector_type(16))) float;
using f32x8  = __attribute__((ext_vector_type(8))) float;
using u32x4  = __attribute__((ext_vector_type(4))) unsigned;
#define KSWZ(row, colB) ((row) * 256 + ((colB) ^ (((row) & KSWZ_MASK) << 4)))
#define SBAR() __builtin_amdgcn_sched_barrier(0)
__device__ __forceinline__ int crow(int r, int hi) { return (r & 3) + 8 * (r >> 2) + 4 * hi; }
__device__ __forceinline__ unsigned cvtpk(float lo, float hi) {
  unsigned r; asm volatile("v_cvt_pk_bf16_f32 %0, %1, %2" : "=v"(r) : "v"(lo), "v"(hi)); return r;
}
__device__ __forceinline__ void partialSM(f32x16& p0, f32x16& p1, float& m_reg, float& mn, float& alpha) {
  constexpr float C = QPRE ? 1.0f : QC;
  float pmax = p0[0]; for (int r = 1; r < 16; ++r) pmax = fmaxf(pmax, p0[r]); for (int r = 0; r < 16; ++r) pmax = fmaxf(pmax, p1[r]);
  { auto rr = __builtin_amdgcn_permlane32_swap(__float_as_uint(pmax), __float_as_uint(pmax), false, false);
    pmax = fmaxf(__uint_as_float(rr[0]), __uint_as_float(rr[1])); }
  if (__builtin_expect(__all(pmax - m_reg <= (QPRE ? THR * 1.4426950408889634f : THR / SCALE)), 1)) { mn = m_reg; alpha = 1.f; }
  else { mn = fmaxf(m_reg, pmax); alpha = __builtin_amdgcn_exp2f((m_reg - mn) * C); m_reg = mn; }
  float mnC = -mn * C;
  for (int r = 0; r < 16; ++r) p0[r] = fmaf(p0[r], C, mnC); for (int r = 0; r < 16; ++r) p1[r] = fmaf(p1[r], C, mnC);
  for (int r = 0; r < 16; ++r) p0[r] = __builtin_amdgcn_exp2f(p0[r]);
}
__device__ __forceinline__ void finishSM(f32x16& p0, f32x16& p1, float alpha, float& l_reg, bf16x8& pa0, bf16x8& pa1, bf16x8& pa2, bf16x8& pa3) {
  for (int r = 0; r < 16; ++r) p1[r] = __builtin_amdgcn_exp2f(p1[r]);
  float ps = 0; for (int r = 0; r < 16; ++r) ps += p0[r]; for (int r = 0; r < 16; ++r) ps += p1[r];
  { auto rr = __builtin_amdgcn_permlane32_swap(__float_as_uint(ps), __float_as_uint(ps), false, false);
    ps = __uint_as_float(rr[0]) + __uint_as_float(rr[1]); }
  l_reg = l_reg * alpha + ps;
#define PK4(P, BASE, OUT) do { unsigned a0 = cvtpk(P[BASE + 0], P[BASE + 1]), a1 = cvtpk(P[BASE + 2], P[BASE + 3]);   \
    unsigned b0 = cvtpk(P[BASE + 4], P[BASE + 5]), b1 = cvtpk(P[BASE + 6], P[BASE + 7]);                              \
    auto r0 = __builtin_amdgcn_permlane32_swap(a0, b0, false, false); auto r1 = __builtin_amdgcn_permlane32_swap(a1, b1, false, false); \
    u32x4 w = {r0[0], r1[0], r0[1], r1[1]}; OUT = *reinterpret_cast<bf16x8*>(&w); } while (0)
  PK4(p0, 0, pa0); PK4(p0, 8, pa1); PK4(p1, 0, pa2); PK4(p1, 8, pa3);
#undef PK4
}
__device__ __forceinline__ void fastSM_exp(f32x16& p0, f32x16& p1, float& l_part) {
  for (int r = 0; r < 16; ++r) p0[r] = __builtin_amdgcn_exp2f(p0[r]);
  for (int r = 0; r < 16; ++r) p1[r] = __builtin_amdgcn_exp2f(p1[r]);
  float ps = 0; for (int r = 0; r < 16; ++r) ps += p0[r]; for (int r = 0; r < 16; ++r) ps += p1[r];
  l_part += ps;
}
__device__ __forceinline__ void fastSM_pack(f32x16& p0, f32x16& p1, bf16x8& pa0, bf16x8& pa1, bf16x8& pa2, bf16x8& pa3) {
#define PK4(P, BASE, OUT) do { unsigned a0 = cvtpk(P[BASE + 0], P[BASE + 1]), a1 = cvtpk(P[BASE + 2], P[BASE + 3]);   \
    unsigned b0 = cvtpk(P[BASE + 4], P[BASE + 5]), b1 = cvtpk(P[BASE + 6], P[BASE + 7]);                              \
    auto r0 = __builtin_amdgcn_permlane32_swap(a0, b0, false, false); auto r1 = __builtin_amdgcn_permlane32_swap(a1, b1, false, false); \
    u32x4 w = {r0[0], r1[0], r0[1], r1[1]}; OUT = *reinterpret_cast<bf16x8*>(&w); } while (0)
  PK4(p0, 0, pa0); PK4(p0, 8, pa1); PK4(p1, 0, pa2); PK4(p1, 8, pa3);
#undef PK4
}
__device__ __forceinline__ void fastSM(f32x16& p0, f32x16& p1, float& l_part, bf16x8& pa0, bf16x8& pa1, bf16x8& pa2, bf16x8& pa3) { fastSM_exp(p0, p1, l_part); fastSM_pack(p0, p1, pa0, pa1, pa2, pa3); }
__device__ __forceinline__ void qkt(f32x16& p0, f32x16& p1, const bf16* Ks, const bf16x8* qr, int r32, int hi) {
  p0 = f32x16{}; p1 = f32x16{};
#ifdef ATTN_PRIO
  __builtin_amdgcn_s_setprio(1);
#endif
  for (int d0 = 0; d0 < 8; ++d0) { int cb = (d0 * 16 + hi * 8) * 2;
    bf16x8 b0 = *reinterpret_cast<const bf16x8*>((const char*)Ks + KSWZ(r32, cb));
    bf16x8 b1 = *reinterpret_cast<const bf16x8*>((const char*)Ks + KSWZ(32 + r32, cb));
    p0 = __builtin_amdgcn_mfma_f32_32x32x16_bf16(b0, qr[d0], p0, 0, 0, 0);
    p1 = __builtin_amdgcn_mfma_f32_32x32x16_bf16(b1, qr[d0], p1, 0, 0, 0); }
#ifdef ATTN_PRIO
  __builtin_amdgcn_s_setprio(0);
#endif
}
__device__ __forceinline__ int v_st(int k, int c) { const int kk = (k & ~0xC) | ((k & 4) << 1) | ((k & 8) >> 1); return ((kk >> 3) * 4 + (c >> 5)) * 512 + ((kk & 7) * 32 + (c & 31)) * 2; }
__device__ __forceinline__ int v_rd_base(int lane) { return ((lane & 3) << 3) | (((lane >> 2) & 3) << 6) | (((lane >> 4) & 1) << 5) | (((lane >> 5) & 1) << 8); }
constexpr int v_rd_off(int d0, int ks, int half) { return d0 * 512 + ks * 4096 + half * 2048; }
template <int OFF> __device__ __forceinline__ s16x4 tr_read(int vb) {
  s16x4 r; asm volatile("ds_read_b64_tr_b16 %0, %1 offset:%2" : "=&v"(r) : "v"(vb), "i"(OFF) : "memory"); return r;
}
template <int D0> __device__ __forceinline__ void pv_one(f32x16& od, int vb, bf16x8 pa0, bf16x8 pa1, bf16x8 pa2, bf16x8 pa3) {
  const s16x4 l0 = tr_read<v_rd_off(D0, 0, 0)>(vb), h0 = tr_read<v_rd_off(D0, 0, 1)>(vb), l1 = tr_read<v_rd_off(D0, 1, 0)>(vb), h1 = tr_read<v_rd_off(D0, 1, 1)>(vb);
  const s16x4 l2 = tr_read<v_rd_off(D0, 2, 0)>(vb), h2 = tr_read<v_rd_off(D0, 2, 1)>(vb), l3 = tr_read<v_rd_off(D0, 3, 0)>(vb), h3 = tr_read<v_rd_off(D0, 3, 1)>(vb);
  asm volatile("s_waitcnt lgkmcnt(0)" ::: "memory"); SBAR();
#define PK(L, H) (bf16x8){L[0], L[1], L[2], L[3], H[0], H[1], H[2], H[3]}
  od = __builtin_amdgcn_mfma_f32_32x32x16_bf16(pa0, PK(l0, h0), od, 0, 0, 0);
  od = __builtin_amdgcn_mfma_f32_32x32x16_bf16(pa1, PK(l1, h1), od, 0, 0, 0);
  od = __builtin_amdgcn_mfma_f32_32x32x16_bf16(pa2, PK(l2, h2), od, 0, 0, 0);
  od = __builtin_amdgcn_mfma_f32_32x32x16_bf16(pa3, PK(l3, h3), od, 0, 0, 0);
#undef PK
}
__device__ __forceinline__ void pv_d0(f32x16* o, int vb, bf16x8 pa0, bf16x8 pa1, bf16x8 pa2, bf16x8 pa3) {
#ifdef ATTN_PRIO
  __builtin_amdgcn_s_setprio(1);
#endif
  pv_one<0>(o[0], vb, pa0, pa1, pa2, pa3); pv_one<1>(o[1], vb, pa0, pa1, pa2, pa3); pv_one<2>(o[2], vb, pa0, pa1, pa2, pa3); pv_one<3>(o[3], vb, pa0, pa1, pa2, pa3);
#ifdef ATTN_PRIO
  __builtin_amdgcn_s_setprio(0);
#endif
}

__device__ __forceinline__ void attn_dense_body(const bf16* __restrict__ Qb, const bf16* __restrict__ Kh, const bf16* __restrict__ Vh,
                                                bf16* __restrict__ Ob, int seq, char* lds) {
  const int tid = threadIdx.x, wid = tid >> 6, lane = tid & 63, r32 = lane & 31, hi = lane >> 5;
  bf16* V_lds = (bf16*)lds; bf16* K_lds = (bf16*)(lds + 2 * SHM_V);
  float* ws = (float*)(lds + 2 * SHM_V + 2 * SHM_K) + wid * 64; float* li_l = ws; float* al_l = ws + 32;
  float m_reg = -1e30f, l_reg = 0; f32x16 o[4] = {}; bf16x8 qr[8];
  const bf16* Qw = Qb + (long)(wid * QBLK + r32) * LDQ + hi * 8;
#pragma unroll
  for (int d0 = 0; d0 < 8; ++d0) qr[d0] = *reinterpret_cast<const bf16x8*>(Qw + d0 * 16);
  const int sr = tid >> 4, sc = (tid & 15) * 8, vst0 = v_st(sr, sc), vst1 = v_st(32 + sr, sc);
  const int vb0 = (int)(uintptr_t)V_lds + v_rd_base(lane);
  struct { bf16x8 vs0, vs1, ks0, ks1; } sr_[SDEPTH];
#define SLOAD(i, k0) do { sr_[i].vs0 = LD8(&Vh[(long)((k0) + sr) * LDK + sc]); sr_[i].vs1 = LD8(&Vh[(long)((k0) + 32 + sr) * LDK + sc]); \
    sr_[i].ks0 = LD8(&Kh[(long)((k0) + sr) * LDK + sc]); sr_[i].ks1 = LD8(&Kh[(long)((k0) + 32 + sr) * LDK + sc]); } while (0)
#define SWRITE(b, i) do { *(bf16x8*)((char*)V_lds + (b) * SHM_V + vst0) = (sr_[i].vs0);          \
    *(bf16x8*)((char*)V_lds + (b) * SHM_V + vst1) = (sr_[i].vs1); int kc = sc * 2;               \
    *(bf16x8*)((char*)K_lds + (b) * SHM_K + KSWZ(sr, kc)) = (sr_[i].ks0);                       \
    *(bf16x8*)((char*)K_lds + (b) * SHM_K + KSWZ(32 + sr, kc)) = (sr_[i].ks1); } while (0)
#define SWAIT() do { if constexpr (SDEPTH == 2) asm volatile("s_waitcnt vmcnt(4)" ::: "memory"); else asm volatile("s_waitcnt vmcnt(0)" ::: "memory"); } while (0)
#define RESC(a) do { if (__any((a) < 1.f)) { if (hi == 0) al_l[r32] = (a); asm volatile("s_waitcnt lgkmcnt(0)" ::: "memory"); \
    for (int d = 0; d < 4; ++d) for (int r = 0; r < 16; ++r) o[d][r] *= al_l[crow(r, hi)]; } } while (0)
  f32x16 pA0, pA1, pB0, pB1; float mnA, mnB, alA, alB; bf16x8 pa0, pa1, pa2, pa3; const int NT = seq / KVBLK;
  constexpr int SE = 0, SO = SDEPTH - 1;
  SLOAD(SE, 0); asm volatile("s_waitcnt vmcnt(0)" ::: "memory"); SWRITE(0, SE); __syncthreads();
  qkt(pA0, pA1, K_lds, qr, r32, hi); partialSM(pA0, pA1, m_reg, mnA, alA);
  SLOAD(SO, KVBLK); if constexpr (SDEPTH == 2) { if (2 < NT) SLOAD(SE, 2 * KVBLK); }
  SWAIT(); SWRITE(1, SO); __syncthreads();
  for (int j = 1; j + 1 < NT; j += 2) {
    SBAR(); qkt(pB0, pB1, (bf16*)((char*)K_lds + SHM_K), qr, r32, hi);
    finishSM(pA0, pA1, alA, l_reg, pa0, pa1, pa2, pa3); SBAR();
    SLOAD(SO, (j + SDEPTH) * KVBLK); SBAR();
    pv_d0(o, vb0, pa0, pa1, pa2, pa3); partialSM(pB0, pB1, m_reg, mnB, alB);
    __syncthreads(); SWAIT(); SWRITE(0, SE);
    RESC(alB); __syncthreads();
    SBAR(); qkt(pA0, pA1, K_lds, qr, r32, hi);
    finishSM(pB0, pB1, alB, l_reg, pa0, pa1, pa2, pa3); SBAR();
    if (SDEPTH == 1 || j + 3 < NT) SLOAD(SE, (j + 1 + SDEPTH) * KVBLK); SBAR();
    pv_d0(o, vb0 + (int)SHM_V, pa0, pa1, pa2, pa3); partialSM(pA0, pA1, m_reg, mnA, alA);
    __syncthreads(); SWAIT(); SWRITE(1, SO);
    RESC(alA); __syncthreads();
  }
  SBAR(); qkt(pB0, pB1, (bf16*)((char*)K_lds + SHM_K), qr, r32, hi);
  finishSM(pA0, pA1, alA, l_reg, pa0, pa1, pa2, pa3); SBAR();
  pv_d0(o, vb0, pa0, pa1, pa2, pa3); partialSM(pB0, pB1, m_reg, mnB, alB);
  __syncthreads(); RESC(alB);
  finishSM(pB0, pB1, alB, l_reg, pa0, pa1, pa2, pa3); SBAR();
  pv_d0(o, vb0 + (int)SHM_V, pa0, pa1, pa2, pa3);
  if (hi == 0) li_l[r32] = l_reg; asm volatile("s_waitcnt lgkmcnt(0)" ::: "memory");
  float rli[16];
#pragma unroll
  for (int r = 0; r < 16; ++r) rli[r] = __builtin_amdgcn_rcpf(li_l[crow(r, hi)]);
  bf16* Ow = Ob + (long)(wid * QBLK) * LDO;
#pragma unroll
  for (int r = 0; r < 16; ++r) { int orow = crow(r, hi);
    for (int d0 = 0; d0 < 4; ++d0) Ow[(long)orow * LDO + d0 * 32 + r32] = (bf16)(cvtpk(o[d0][r] * rli[r], 0.f) & 0xffffu); }
#undef SLOAD
#undef SWRITE
#undef SWAIT
#undef RESC
}


#define DSR128(dst, addr, off) asm volatile("ds_read_b128 %0, %1 offset:%2" : "=&v"(dst) : "v"(addr), "i"(off) : "memory")
#define LGKM(n) do { SBAR(); asm volatile("s_waitcnt lgkmcnt(" #n ")" ::: "memory"); SBAR(); } while (0)
struct VChunk { s16x4 l0, h0, l1, h1, l2, h2, l3, h3; };
struct KChunk { bf16x8 a0, a1, b0, b1; };
template <int D0> __device__ __forceinline__ void v_issue(VChunk& c, int vb) {
  c.l0 = tr_read<v_rd_off(D0, 0, 0)>(vb); c.h0 = tr_read<v_rd_off(D0, 0, 1)>(vb); c.l1 = tr_read<v_rd_off(D0, 1, 0)>(vb); c.h1 = tr_read<v_rd_off(D0, 1, 1)>(vb);
  c.l2 = tr_read<v_rd_off(D0, 2, 0)>(vb); c.h2 = tr_read<v_rd_off(D0, 2, 1)>(vb); c.l3 = tr_read<v_rd_off(D0, 3, 0)>(vb); c.h3 = tr_read<v_rd_off(D0, 3, 1)>(vb);
}
__device__ __forceinline__ void v_mma(f32x16& od, const VChunk& c, bf16x8 pa0, bf16x8 pa1, bf16x8 pa2, bf16x8 pa3) {
#define PK(L, H) (bf16x8){L[0], L[1], L[2], L[3], H[0], H[1], H[2], H[3]}
  od = __builtin_amdgcn_mfma_f32_32x32x16_bf16(pa0, PK(c.l0, c.h0), od, 0, 0, 0); od = __builtin_amdgcn_mfma_f32_32x32x16_bf16(pa1, PK(c.l1, c.h1), od, 0, 0, 0);
  od = __builtin_amdgcn_mfma_f32_32x32x16_bf16(pa2, PK(c.l2, c.h2), od, 0, 0, 0); od = __builtin_amdgcn_mfma_f32_32x32x16_bf16(pa3, PK(c.l3, c.h3), od, 0, 0, 0);
#undef PK
}
template <int C> __device__ __forceinline__ void k_issue(KChunk& c, int krow, int sxh) {
  const int ad0 = krow + (((2 * C) * 32) ^ sxh), ad1 = krow + (((2 * C + 1) * 32) ^ sxh);
  DSR128(c.a0, ad0, 0); DSR128(c.a1, ad0, 32 * 256); DSR128(c.b0, ad1, 0); DSR128(c.b1, ad1, 32 * 256);
}
template <int C> __device__ __forceinline__ void k_mma(f32x16& p0, f32x16& p1, const KChunk& c, const bf16x8* qr) {
  if (C == 0) { p0 = __builtin_amdgcn_mfma_f32_32x32x16_bf16(c.a0, qr[0], f32x16{}, 0, 0, 0); p1 = __builtin_amdgcn_mfma_f32_32x32x16_bf16(c.a1, qr[0], f32x16{}, 0, 0, 0); }
  else { p0 = __builtin_amdgcn_mfma_f32_32x32x16_bf16(c.a0, qr[2 * C], p0, 0, 0, 0); p1 = __builtin_amdgcn_mfma_f32_32x32x16_bf16(c.a1, qr[2 * C], p1, 0, 0, 0); }
  p0 = __builtin_amdgcn_mfma_f32_32x32x16_bf16(c.b0, qr[2 * C + 1], p0, 0, 0, 0); p1 = __builtin_amdgcn_mfma_f32_32x32x16_bf16(c.b1, qr[2 * C + 1], p1, 0, 0, 0);
}
#ifndef PP_EARLY_LOADS
#define PP_EARLY_LOADS 1
#endif
#ifndef PP_KDEEP
#define PP_KDEEP 0
#endif
#ifndef PP_SPLIT
#define PP_SPLIT 0
#endif
#ifndef PP_VPREFETCH
#define PP_VPREFETCH 0
#endif
#ifndef PP_FAST_WRITES_FIRST
#define PP_FAST_WRITES_FIRST 1
#endif
#ifndef PP_PRIO_X
#define PP_PRIO_X 1
#endif
#ifndef PP_PRIO_Y
#define PP_PRIO_Y 0
#endif
constexpr size_t SHM_PP = 3 * SHM_K + 3 * SHM_V + NW * 64 * 4;
#define PP_BAR() asm volatile("s_waitcnt lgkmcnt(0)\n\ts_barrier" ::: "memory")
#ifdef PROBE_PP_T
#define PP_T(k) do { const unsigned long long t_ = __builtin_amdgcn_s_memtime(); tacc[k] += t_ - tlast; tlast = t_; } while (0)
#else
#define PP_T(k) do { } while (0)
#endif
template <bool FAST  >
__device__ __forceinline__ void attn_pp_body(const bf16* __restrict__ Qb, const bf16* __restrict__ Kh, const bf16* __restrict__ Vh, bf16* __restrict__ Ob, int seq, char* lds, unsigned long long* tacc_out = nullptr) {
#ifdef PROBE_PP_T
  unsigned long long tacc[4] = {0ull, 0ull, 0ull, 0ull}, tlast = 0ull;
#endif
  int tid_ = threadIdx.x; asm volatile("" : "+v"(tid_));
  const int tid = tid_, wid = __builtin_amdgcn_readfirstlane(tid >> 6), lane = tid & 63, r32 = lane & 31, hi = lane >> 5;
  const bool trailing = wid >= 4;
  char* const K_lds = lds; char* const V_lds = lds + 3 * SHM_K;
  float* ws = (float*)(lds + 3 * SHM_K + 3 * SHM_V) + wid * 64; float* li_l = ws; float* al_l = ws + 32;
  float m_reg = -1e30f, l_reg = 0; f32x16 o[4] = {}; bf16x8 qr[8];
  const bf16* Qw = Qb + (long)(wid * QBLK + r32) * LDQ + hi * 8;
#pragma unroll
  for (int d0 = 0; d0 < 8; ++d0) qr[d0] = *reinterpret_cast<const bf16x8*>(Qw + d0 * 16);
  const int sr = tid >> 4, sc = (tid & 15) * 8, vst0 = v_st(sr, sc), vst1 = v_st(32 + sr, sc), kst0 = KSWZ(sr, sc * 2), kst1 = KSWZ(32 + sr, sc * 2);
  const int vb0 = (int)(uintptr_t)V_lds + v_rd_base(lane), sx6 = ((r32 & KSWZ_MASK) << 4) & 0xE0, krow = (int)(uintptr_t)K_lds + r32 * 256 + ((hi * 16) ^ (((r32 & KSWZ_MASK) << 4) & 0x10));
  const int NT = seq / KVBLK;
  const bf16* const Kt = Kh + (long)sr * LDK + sc; const bf16* const Vt = Vh + (long)sr * LDK + sc;
#define PP_TILE(base, t) ((base) + (long)(t) * (KVBLK * LDK))
#define RESC(a) do { if (__any((a) < 1.f)) { if (hi == 0) al_l[r32] = (a); asm volatile("s_waitcnt lgkmcnt(0)" ::: "memory"); \
    for (int d = 0; d < 4; ++d) for (int r = 0; r < 16; ++r) o[d][r] *= al_l[crow(r, hi)]; } } while (0)
  {
    const bf16x8 a0 = LD8(PP_TILE(Kt, 0)), a1 = LD8(PP_TILE(Kt, 0) + 32 * LDK), b0 = LD8(PP_TILE(Kt, 1)), b1 = LD8(PP_TILE(Kt, 1) + 32 * LDK), c0 = LD8(PP_TILE(Kt, 2)), c1 = LD8(PP_TILE(Kt, 2) + 32 * LDK);
    const bf16x8 d0 = LD8(PP_TILE(Vt, 0)), d1 = LD8(PP_TILE(Vt, 0) + 32 * LDK), e0 = LD8(PP_TILE(Vt, 1)), e1 = LD8(PP_TILE(Vt, 1) + 32 * LDK);
    *(bf16x8*)(K_lds + 0 * SHM_K + kst0) = a0; *(bf16x8*)(K_lds + 0 * SHM_K + kst1) = a1; *(bf16x8*)(K_lds + 1 * SHM_K + kst0) = b0; *(bf16x8*)(K_lds + 1 * SHM_K + kst1) = b1;
    *(bf16x8*)(K_lds + 2 * SHM_K + kst0) = c0; *(bf16x8*)(K_lds + 2 * SHM_K + kst1) = c1;
    *(bf16x8*)(V_lds + 0 * SHM_V + vst0) = d0; *(bf16x8*)(V_lds + 0 * SHM_V + vst1) = d1; *(bf16x8*)(V_lds + 1 * SHM_V + vst0) = e0; *(bf16x8*)(V_lds + 1 * SHM_V + vst1) = e1;
  }
  PP_BAR();
  f32x16 s0, s1; float mn, al; bf16x8 pa0, pa1, pa2, pa3;
  qkt(s0, s1, (const bf16*)K_lds, qr, r32, hi);
  if constexpr (FAST) fastSM(s0, s1, l_reg, pa0, pa1, pa2, pa3);
  else { partialSM(s0, s1, m_reg, mn, al); finishSM(s0, s1, al, l_reg, pa0, pa1, pa2, pa3); }
  VChunk v0, v1;
  constexpr bool VPRE = FAST && PP_VPREFETCH != 0;
  if constexpr (VPRE) { v_issue<0>(v0, vb0); }
  if (trailing) PP_BAR();
  LGKM(0);
  int kr = 1, vr = 0, kw = 0, vw = 2;
#ifdef PROBE_PP_T
  tlast = __builtin_amdgcn_s_memtime();
#endif
  for (int i = 0; i < NT; ++i) {
#if PP_EARLY_LOADS
    const int tk = (i + 3 < NT) ? i + 3 : NT - 1, tv = (i + 2 < NT) ? i + 2 : NT - 1;
    const bf16x8 gk0 = LD8(PP_TILE(Kt, tk)), gk1 = LD8(PP_TILE(Kt, tk) + 32 * LDK), gv0 = LD8(PP_TILE(Vt, tv)), gv1 = LD8(PP_TILE(Vt, tv) + 32 * LDK);
#endif
    SBAR(); __builtin_amdgcn_s_setprio(PP_PRIO_X);
    if constexpr (FAST && PP_SPLIT != 0) {
      const int vb = vb0 + vr * (int)SHM_V, kro = krow + kr * (int)SHM_K;
      v_issue<0>(v0, vb); v_issue<1>(v1, vb);
      if (i + 1 < NT) { KChunk k0, k1, k2, k3;
        LGKM(8); v_mma(o[0], v0, pa0, pa1, pa2, pa3); k_issue<0>(k0, kro, sx6);
        LGKM(4); v_mma(o[1], v1, pa0, pa1, pa2, pa3); k_issue<1>(k1, kro, sx6);
        LGKM(4); k_mma<0>(s0, s1, k0, qr); k_issue<2>(k2, kro, sx6);
        LGKM(4); k_mma<1>(s0, s1, k1, qr); k_issue<3>(k3, kro, sx6);
        LGKM(4); k_mma<2>(s0, s1, k2, qr);
        LGKM(0); k_mma<3>(s0, s1, k3, qr);
      } else { LGKM(8); v_mma(o[0], v0, pa0, pa1, pa2, pa3); LGKM(0); v_mma(o[1], v1, pa0, pa1, pa2, pa3); }
    } else if constexpr (FAST && PP_KDEEP != 0) {
      const int vb = vb0 + vr * (int)SHM_V, kro = krow + kr * (int)SHM_K; VChunk v2, v3;
      v_issue<0>(v0, vb); v_issue<1>(v1, vb);
      LGKM(8); v_mma(o[0], v0, pa0, pa1, pa2, pa3); v_issue<2>(v2, vb);
      LGKM(8); v_mma(o[1], v1, pa0, pa1, pa2, pa3); v_issue<3>(v3, vb);
      if (i + 1 < NT) { KChunk k0, k1, k2, k3;
        LGKM(8); k_issue<0>(k0, kro, sx6); v_mma(o[2], v2, pa0, pa1, pa2, pa3);
        LGKM(4); k_issue<1>(k1, kro, sx6); k_issue<2>(k2, kro, sx6); v_mma(o[3], v3, pa0, pa1, pa2, pa3);
        LGKM(8); k_mma<0>(s0, s1, k0, qr); k_issue<3>(k3, kro, sx6);
        LGKM(8); k_mma<1>(s0, s1, k1, qr);
        LGKM(4); k_mma<2>(s0, s1, k2, qr);
        LGKM(0); k_mma<3>(s0, s1, k3, qr);
      } else { LGKM(8); v_mma(o[2], v2, pa0, pa1, pa2, pa3); LGKM(0); v_mma(o[3], v3, pa0, pa1, pa2, pa3); }
    } else
    { const int vb = vb0 + vr * (int)SHM_V, kro = krow + kr * (int)SHM_K; VChunk v2, v3;
      if constexpr (VPRE) { v_issue<1>(v1, vb); v_issue<2>(v2, vb);
        SBAR(); v_mma(o[0], v0, pa0, pa1, pa2, pa3);
        LGKM(8); v_mma(o[1], v1, pa0, pa1, pa2, pa3); v_issue<3>(v3, vb); }
      else { v_issue<0>(v0, vb); v_issue<1>(v1, vb);
        LGKM(8); v_mma(o[0], v0, pa0, pa1, pa2, pa3); v_issue<2>(v2, vb);
        LGKM(8); v_mma(o[1], v1, pa0, pa1, pa2, pa3); v_issue<3>(v3, vb); }
      if (i + 1 < NT) { KChunk k0, k1, k2, k3;
        LGKM(8); v_mma(o[2], v2, pa0, pa1, pa2, pa3); k_issue<0>(k0, kro, sx6);
        LGKM(4); v_mma(o[3], v3, pa0, pa1, pa2, pa3); k_issue<1>(k1, kro, sx6);
        LGKM(4); k_mma<0>(s0, s1, k0, qr); k_issue<2>(k2, kro, sx6);
        LGKM(4); k_mma<1>(s0, s1, k1, qr); k_issue<3>(k3, kro, sx6);
        LGKM(4); k_mma<2>(s0, s1, k2, qr);
        LGKM(0); k_mma<3>(s0, s1, k3, qr);
      } else { LGKM(8); v_mma(o[2], v2, pa0, pa1, pa2, pa3); LGKM(0); v_mma(o[3], v3, pa0, pa1, pa2, pa3); }
    }
#ifdef PROBE_PP_X
    { f32x16 dm = {}; for (int q = 0; q < PROBE_PP_X; ++q) dm = __builtin_amdgcn_mfma_f32_32x32x16_bf16(qr[q & 7], qr[(q + 1) & 7], dm, 0, 0, 0); asm volatile("" :: "v"(dm)); }
#endif
    __builtin_amdgcn_s_setprio(PP_PRIO_Y);
    PP_T(0);
    PP_BAR();
    PP_T(1);
#ifdef PROBE_PP_Y
    { float dt = (float)i; for (int q = 0; q < PROBE_PP_Y; ++q) dt = fmaf(dt, 1.0001f, 0.5f); asm volatile("" :: "v"(dt)); }
#endif
#if !PP_EARLY_LOADS
    const int tk = (i + 3 < NT) ? i + 3 : NT - 1, tv = (i + 2 < NT) ? i + 2 : NT - 1;
    const bf16x8 gk0 = LD8(PP_TILE(Kt, tk)), gk1 = LD8(PP_TILE(Kt, tk) + 32 * LDK), gv0 = LD8(PP_TILE(Vt, tv)), gv1 = LD8(PP_TILE(Vt, tv) + 32 * LDK);
    SBAR();
#endif
    const int vbn = vb0 + (vr == 2 ? 0 : vr + 1) * (int)SHM_V;
    if constexpr (FAST) {
#if PP_FAST_WRITES_FIRST
      *(bf16x8*)(K_lds + kw * SHM_K + kst0) = gk0; *(bf16x8*)(K_lds + kw * SHM_K + kst1) = gk1; *(bf16x8*)(V_lds + vw * SHM_V + vst0) = gv0; *(bf16x8*)(V_lds + vw * SHM_V + vst1) = gv1;
#endif
#if PP_SPLIT
      { const int vb = vb0 + vr * (int)SHM_V;
        SBAR(); v_issue<2>(v0, vb); v_issue<3>(v1, vb); SBAR();
        if (i + 1 < NT) fastSM_exp(s0, s1, l_reg);
        LGKM(8); v_mma(o[2], v0, pa0, pa1, pa2, pa3); LGKM(0); v_mma(o[3], v1, pa0, pa1, pa2, pa3); SBAR();
        if (i + 1 < NT) fastSM_pack(s0, s1, pa0, pa1, pa2, pa3); }
#else
      if (i + 1 < NT) { if constexpr (VPRE) { SBAR(); v_issue<0>(v0, vbn); SBAR(); } fastSM(s0, s1, l_reg, pa0, pa1, pa2, pa3); }
#endif
#if !PP_FAST_WRITES_FIRST
      *(bf16x8*)(K_lds + kw * SHM_K + kst0) = gk0; *(bf16x8*)(K_lds + kw * SHM_K + kst1) = gk1; *(bf16x8*)(V_lds + vw * SHM_V + vst0) = gv0; *(bf16x8*)(V_lds + vw * SHM_V + vst1) = gv1;
#endif
    } else {
    if (i + 1 < NT) { partialSM(s0, s1, m_reg, mn, al); finishSM(s0, s1, al, l_reg, pa0, pa1, pa2, pa3); RESC(al); }
    *(bf16x8*)(K_lds + kw * SHM_K + kst0) = gk0; *(bf16x8*)(K_lds + kw * SHM_K + kst1) = gk1; *(bf16x8*)(V_lds + vw * SHM_V + vst0) = gv0; *(bf16x8*)(V_lds + vw * SHM_V + vst1) = gv1;
    }
    PP_T(2);
    PP_BAR();
    PP_T(3);
    kr = (kr == 2) ? 0 : kr + 1; vr = (vr == 2) ? 0 : vr + 1; kw = (kw == 2) ? 0 : kw + 1; vw = (vw == 2) ? 0 : vw + 1;
  }
#ifdef PROBE_PP_T
  if (tacc_out && tid == 0 && blockIdx.x == 0) { tacc_out[0] += tacc[0]; tacc_out[1] += tacc[1]; tacc_out[2] += tacc[2]; tacc_out[3] += tacc[3]; }
#endif
  __builtin_amdgcn_s_setprio(0);
  if (!trailing) PP_BAR();
  if constexpr (FAST) { auto rr = __builtin_amdgcn_permlane32_swap(__float_as_uint(l_reg), __float_as_uint(l_reg), false, false); l_reg = __uint_as_float(rr[0]) + __uint_as_float(rr[1]); }
  if (hi == 0) li_l[r32] = l_reg; asm volatile("s_waitcnt lgkmcnt(0)" ::: "memory");
  float rli[16];
#pragma unroll
  for (int r = 0; r < 16; ++r) rli[r] = __builtin_amdgcn_rcpf(li_l[crow(r, hi)]);
  bf16* Ow = Ob + (long)(wid * QBLK) * LDO;
#pragma unroll
  for (int r = 0; r < 16; ++r) { int orow = crow(r, hi);
    for (int d0 = 0; d0 < 4; ++d0) Ow[(long)orow * LDO + d0 * 32 + r32] = (bf16)(cvtpk(o[d0][r] * rli[r], 0.f) & 0xffffu); }
#undef RESC
#undef PP_TILE
}

struct C4 { bf16x8 a, b, c, d; };
using f32x4 = __attribute__((ext_vector_type(4))) float;
__device__ __forceinline__ f32x4 MFMA16(bf16x8 a, bf16x8 b, f32x4 c) { return __builtin_amdgcn_mfma_f32_16x16x32_bf16(a, b, c, 0, 0, 0); }
template <int G> __device__ __forceinline__ void v16_issue(C4& c, int va0, int va1) {
  DSR128(c.a, va0, (2 * G) * 2048); DSR128(c.b, va1, (2 * G) * 2048); DSR128(c.c, va0, (2 * G + 1) * 2048); DSR128(c.d, va1, (2 * G + 1) * 2048);
}
template <int G> __device__ __forceinline__ void v16_mma(f32x4 (&o)[2][8], const C4& c, const bf16x8 (&pa)[2][2]) {
  o[0][2 * G] = MFMA16(pa[0][0], c.a, o[0][2 * G]); o[1][2 * G] = MFMA16(pa[1][0], c.a, o[1][2 * G]); o[0][2 * G + 1] = MFMA16(pa[0][0], c.c, o[0][2 * G + 1]); o[1][2 * G + 1] = MFMA16(pa[1][0], c.c, o[1][2 * G + 1]);
  o[0][2 * G] = MFMA16(pa[0][1], c.b, o[0][2 * G]); o[1][2 * G] = MFMA16(pa[1][1], c.b, o[1][2 * G]); o[0][2 * G + 1] = MFMA16(pa[0][1], c.d, o[0][2 * G + 1]); o[1][2 * G + 1] = MFMA16(pa[1][1], c.d, o[1][2 * G + 1]);
}
template <int KB> __device__ __forceinline__ void k16_issue(C4& c, int ka0, int ka1, int ka2, int ka3) {
  DSR128(c.a, ka0, KB * 4096); DSR128(c.b, ka1, KB * 4096); DSR128(c.c, ka2, KB * 4096); DSR128(c.d, ka3, KB * 4096);
}
template <int KB> __device__ __forceinline__ void k16_mma(f32x4 (&s)[4][2], const C4& c, const bf16x8 (&qf)[2][4]) {
  s[KB][0] = MFMA16(c.a, qf[0][0], (f32x4){0.f, 0.f, 0.f, 0.f}); s[KB][1] = MFMA16(c.a, qf[1][0], (f32x4){0.f, 0.f, 0.f, 0.f});
  s[KB][0] = MFMA16(c.b, qf[0][1], s[KB][0]); s[KB][1] = MFMA16(c.b, qf[1][1], s[KB][1]);
  s[KB][0] = MFMA16(c.c, qf[0][2], s[KB][0]); s[KB][1] = MFMA16(c.c, qf[1][2], s[KB][1]);
  s[KB][0] = MFMA16(c.d, qf[0][3], s[KB][0]); s[KB][1] = MFMA16(c.d, qf[1][3], s[KB][1]);
}
__device__ __forceinline__ void fastSM16(f32x4 (&s)[4][2], float (&l)[2], bf16x8 (&pa)[2][2]) {
#pragma unroll
  for (int kb = 0; kb < 4; ++kb)
#pragma unroll
    for (int qb = 0; qb < 2; ++qb)
#pragma unroll
      for (int j = 0; j < 4; ++j) s[kb][qb][j] = __builtin_amdgcn_exp2f(s[kb][qb][j]);
#pragma unroll
  for (int qb = 0; qb < 2; ++qb) { float ps = 0.f;
#pragma unroll
    for (int kb = 0; kb < 4; ++kb) ps += (s[kb][qb][0] + s[kb][qb][1]) + (s[kb][qb][2] + s[kb][qb][3]);
    l[qb] += ps;
#pragma unroll
    for (int s2 = 0; s2 < 2; ++s2) { u32x4 w = {cvtpk(s[2 * s2][qb][0], s[2 * s2][qb][1]), cvtpk(s[2 * s2][qb][2], s[2 * s2][qb][3]), cvtpk(s[2 * s2 + 1][qb][0], s[2 * s2 + 1][qb][1]), cvtpk(s[2 * s2 + 1][qb][2], s[2 * s2 + 1][qb][3])};
      pa[qb][s2] = *reinterpret_cast<bf16x8*>(&w); } }
}
#ifndef PP16_EARLY_LOADS
#define PP16_EARLY_LOADS 1
#endif
__device__ __forceinline__ void attn_pp16_body(const bf16* __restrict__ Qb, const bf16* __restrict__ Kh, const bf16* __restrict__ VTh, bf16* __restrict__ Ob, int seq, char* lds) {
  int tid_ = threadIdx.x; asm volatile("" : "+v"(tid_));
  const int tid = tid_, wid = __builtin_amdgcn_readfirstlane(tid >> 6), lane = tid & 63, fr = lane & 15, fq = lane >> 4;
  const bool trailing = wid >= 4;
  char* const K_lds = lds; char* const V_lds = lds + 3 * SHM_K;
  float* li_l = (float*)(lds + 3 * SHM_K + 3 * SHM_V) + wid * 64;
  f32x4 o[2][8]; bf16x8 qf[2][4]; float l[2] = {0.f, 0.f};
#pragma unroll
  for (int qb = 0; qb < 2; ++qb)
#pragma unroll
    for (int cb = 0; cb < 8; ++cb) o[qb][cb] = (f32x4){0.f, 0.f, 0.f, 0.f};
#pragma unroll
  for (int qb = 0; qb < 2; ++qb)
#pragma unroll
    for (int ds = 0; ds < 4; ++ds) qf[qb][ds] = *reinterpret_cast<const bf16x8*>(Qb + (long)(wid * QBLK + 16 * qb + fr) * LDQ + 32 * ds + 8 * fq);
  const int sr = tid >> 4, sc = (tid & 15) * 8, kst0 = KSWZ(sr, sc * 2), kst1 = KSWZ(32 + sr, sc * 2);
  const int vd = tid >> 3, vc = tid & 7, vst0 = vd * 128 + ((vc ^ ((vd >> 1) & 7)) << 4), vst1 = vst0 + 64 * 128;
  const bf16* const Kt = Kh + (long)sr * LDK + sc; const bf16* const Vt = VTh + tid * 8;
  const int kb_ = (int)(uintptr_t)K_lds + fr * 256, vb_ = (int)(uintptr_t)V_lds + fr * 128;
  const int ko0 = kb_ + (((0 + fq) ^ fr) << 4), ko1 = kb_ + (((4 + fq) ^ fr) << 4), ko2 = kb_ + (((8 + fq) ^ fr) << 4), ko3 = kb_ + (((12 + fq) ^ fr) << 4);
  const int vo0 = vb_ + (((0 + fq) ^ ((fr >> 1) & 7)) << 4), vo1 = vb_ + (((4 + fq) ^ ((fr >> 1) & 7)) << 4);
  const int NT = seq / KVBLK;
#define PP_TILE(base, t) ((base) + (long)(t) * (KVBLK * LDK))
#define PP_VTILE(t) (Vt + (long)(t) * (KVBLK * D))
  { const bf16x8 a0 = LD8(PP_TILE(Kt, 0)), a1 = LD8(PP_TILE(Kt, 0) + 32 * LDK), b0 = LD8(PP_TILE(Kt, 1)), b1 = LD8(PP_TILE(Kt, 1) + 32 * LDK), c0 = LD8(PP_TILE(Kt, 2)), c1 = LD8(PP_TILE(Kt, 2) + 32 * LDK);
    const bf16x8 d0 = LD8(PP_VTILE(0)), d1 = LD8(PP_VTILE(0) + 4096), e0 = LD8(PP_VTILE(1)), e1 = LD8(PP_VTILE(1) + 4096);
    *(bf16x8*)(K_lds + 0 * SHM_K + kst0) = a0; *(bf16x8*)(K_lds + 0 * SHM_K + kst1) = a1; *(bf16x8*)(K_lds + 1 * SHM_K + kst0) = b0; *(bf16x8*)(K_lds + 1 * SHM_K + kst1) = b1;
    *(bf16x8*)(K_lds + 2 * SHM_K + kst0) = c0; *(bf16x8*)(K_lds + 2 * SHM_K + kst1) = c1;
    *(bf16x8*)(V_lds + 0 * SHM_V + vst0) = d0; *(bf16x8*)(V_lds + 0 * SHM_V + vst1) = d1; *(bf16x8*)(V_lds + 1 * SHM_V + vst0) = e0; *(bf16x8*)(V_lds + 1 * SHM_V + vst1) = e1;
  }
  PP_BAR();
  f32x4 s[4][2]; bf16x8 pa[2][2];
  { C4 k0, k1, k2, k3;
    k16_issue<0>(k0, ko0, ko1, ko2, ko3); k16_issue<1>(k1, ko0, ko1, ko2, ko3); k16_issue<2>(k2, ko0, ko1, ko2, ko3);
    LGKM(8); k16_mma<0>(s, k0, qf); k16_issue<3>(k3, ko0, ko1, ko2, ko3);
    LGKM(8); k16_mma<1>(s, k1, qf); LGKM(4); k16_mma<2>(s, k2, qf); LGKM(0); k16_mma<3>(s, k3, qf); }
  fastSM16(s, l, pa);
  if (trailing) PP_BAR();
  int kr = 1, vr = 0, kw = 0, vw = 2;
  for (int i = 0; i < NT; ++i) {
    const int tk = (i + 3 < NT) ? i + 3 : NT - 1, tv = (i + 2 < NT) ? i + 2 : NT - 1;
#if PP16_EARLY_LOADS
    const bf16x8 gk0 = LD8(PP_TILE(Kt, tk)), gk1 = LD8(PP_TILE(Kt, tk) + 32 * LDK), gv0 = LD8(PP_VTILE(tv)), gv1 = LD8(PP_VTILE(tv) + 4096);
#endif
    SBAR(); __builtin_amdgcn_s_setprio(PP_PRIO_X);
    { const int vs = vr * (int)SHM_V, ks = kr * (int)SHM_K, va0 = vo0 + vs, va1 = vo1 + vs, ka0 = ko0 + ks, ka1 = ko1 + ks, ka2 = ko2 + ks, ka3 = ko3 + ks;
      C4 b0, b1, b2;
      v16_issue<0>(b0, va0, va1); v16_issue<1>(b1, va0, va1);
      v16_issue<2>(b2, va0, va1); LGKM(8); v16_mma<0>(o, b0, pa);
      v16_issue<3>(b0, va0, va1); LGKM(8); v16_mma<1>(o, b1, pa);
      if (i + 1 < NT) {
        k16_issue<0>(b1, ka0, ka1, ka2, ka3); LGKM(8); v16_mma<2>(o, b2, pa);
        k16_issue<1>(b2, ka0, ka1, ka2, ka3); LGKM(8); v16_mma<3>(o, b0, pa);
        k16_issue<2>(b0, ka0, ka1, ka2, ka3); LGKM(8); k16_mma<0>(s, b1, qf);
        k16_issue<3>(b1, ka0, ka1, ka2, ka3); LGKM(8); k16_mma<1>(s, b2, qf);
        LGKM(4); k16_mma<2>(s, b0, qf);
        LGKM(0); k16_mma<3>(s, b1, qf);
      } else { LGKM(4); v16_mma<2>(o, b2, pa); LGKM(0); v16_mma<3>(o, b0, pa); }
    }
    __builtin_amdgcn_s_setprio(PP_PRIO_Y);
    PP_BAR();
#if !PP16_EARLY_LOADS
    const bf16x8 gk0 = LD8(PP_TILE(Kt, tk)), gk1 = LD8(PP_TILE(Kt, tk) + 32 * LDK), gv0 = LD8(PP_VTILE(tv)), gv1 = LD8(PP_VTILE(tv) + 4096);
    SBAR();
#endif
    if (i + 1 < NT) fastSM16(s, l, pa);
    *(bf16x8*)(K_lds + kw * SHM_K + kst0) = gk0; *(bf16x8*)(K_lds + kw * SHM_K + kst1) = gk1; *(bf16x8*)(V_lds + vw * SHM_V + vst0) = gv0; *(bf16x8*)(V_lds + vw * SHM_V + vst1) = gv1;
    PP_BAR();
    kr = (kr == 2) ? 0 : kr + 1; vr = (vr == 2) ? 0 : vr + 1; kw = (kw == 2) ? 0 : kw + 1; vw = (vw == 2) ? 0 : vw + 1;
  }
  __builtin_amdgcn_s_setprio(0);
  if (!trailing) PP_BAR();
#pragma unroll
  for (int qb = 0; qb < 2; ++qb) { l[qb] += __shfl_xor(l[qb], 16); l[qb] += __shfl_xor(l[qb], 32); }
  if (fq == 0) { li_l[fr] = l[0]; li_l[16 + fr] = l[1]; }
  asm volatile("s_waitcnt lgkmcnt(0)" ::: "memory");
  bf16* Ow = Ob + (long)(wid * QBLK) * LDO;
#pragma unroll
  for (int qb = 0; qb < 2; ++qb)
#pragma unroll
    for (int j = 0; j < 4; ++j) { const int row = 16 * qb + 4 * fq + j; const float rl = __builtin_amdgcn_rcpf(li_l[row]);
#pragma unroll
      for (int cb = 0; cb < 8; ++cb) Ow[(long)row * LDO + 16 * cb + fr] = (bf16)(cvtpk(o[qb][cb][j] * rl, 0.f) & 0xffffu); }
#undef PP_TILE
#undef PP_VTILE
}

#undef LD8
#undef KSWZ
}

constexpr int NWAVES = 8;
#ifndef MK_PER_PHASE
#define MK_PER_PHASE 0
#endif
constexpr int N_PHASES = 15;

constexpr int DM = 4096, FF = 11008, NPROJ = 9216, AW = 2048, KVW = 512, CW = 2048, HD = 128;
constexpr int M_PROMPT = 4 * 4096, M_SAMPLE = 16384, M = M_PROMPT + M_SAMPLE;
constexpr int S_PROMPT = 4096, S_SAMPLE = 16384;
constexpr int PO_Q = 0, PO_K = 2048, PO_V = 2560, PO_B = 3072, PO_C = 5120, PO_H = 7168;
constexpr float EPS = 1e-6f;

constexpr size_t MiB = 1u << 20;
constexpr size_t WS_CTL = 0, CTL_ZERO_BYTES = 288 * 1024;
constexpr size_t WS_ROPE = 1 * MiB;
constexpr size_t WS_RINV = 1 * MiB + 256 * 1024;
constexpr size_t WS_WA = 2 * MiB;
constexpr size_t WS_WD = 174 * MiB;
constexpr size_t WS_WIN = 260 * MiB;
constexpr size_t WS_WOUT = 332 * MiB;
constexpr size_t WS_XN = 364 * MiB;
constexpr size_t WS_Y = 620 * MiB;
constexpr size_t WS_H = 876 * MiB;
constexpr size_t WS_KC = 1564 * MiB, WS_VC = 1596 * MiB;
constexpr size_t WS_END = 1628 * MiB;
static_assert(WS_WA + (size_t)2 * FF * DM * 2 <= WS_WD && WS_WD + (size_t)DM * FF * 2 <= WS_WIN && WS_WIN + (size_t)NPROJ * DM * 2 <= WS_WOUT && WS_WOUT + (size_t)DM * DM * 2 <= WS_XN &&
              WS_XN + (size_t)M * DM * 2 <= WS_Y && WS_Y + (size_t)M * DM * 2 <= WS_H && WS_H + (size_t)M * FF * 2 <= WS_KC && WS_KC + (size_t)4 * M * HD * 2 <= WS_VC && WS_VC + (size_t)4 * M * HD * 2 <= WS_END, "d_ws map");
constexpr int CW_SCW = 16384;
constexpr int CW_SCW2 = CW_SCW + 2 * 11008;
constexpr int CW_SCW1 = CW_SCW2 + 4096;
constexpr int CW_SCW1D = CW_SCW1 + 2 * 11008;
static_assert((size_t)(CW_SCW1D + 4096) * 4 <= CTL_ZERO_BYTES, "control words inside the zeroed region");
constexpr int CW_BAR = 1024;
constexpr int RING_OFF = 0, RING_BYTES = 131072;
constexpr int MISC_OFF = RING_BYTES;
constexpr int LDS_BYTES = 147456;

#define GAS __attribute__((address_space(1)))
#define LAS __attribute__((address_space(3)))
typedef unsigned short bf16;
typedef unsigned v4u __attribute__((ext_vector_type(4)));
typedef unsigned v2u __attribute__((ext_vector_type(2)));
typedef float f32x4 __attribute__((ext_vector_type(4)));
typedef float f32x2 __attribute__((ext_vector_type(2)));
#define LDS_WAIT() asm volatile("s_waitcnt lgkmcnt(0)" ::: "memory")
#define VM_WAIT() asm volatile("s_waitcnt vmcnt(0)" ::: "memory")
__device__ __forceinline__ unsigned pk2(float lo, float hi) { unsigned r; asm volatile("v_cvt_pk_bf16_f32 %0, %1, %2" : "=v"(r) : "v"(lo), "v"(hi)); return r; }
__device__ __forceinline__ float bflo(unsigned w) { return __uint_as_float(w << 16); }
__device__ __forceinline__ float bfhi(unsigned w) { return __uint_as_float(w & 0xffff0000u); }
__device__ __forceinline__ float wave_sum(float v) {
#pragma unroll
    for (int o = 1; o < 64; o <<= 1) v += __shfl_xor(v, o);
    return v;
}
#define XB_TMO      128
#define XB_XCNT(j)  (256  + 64 * (j))
#define XB_XSUB(j)  (1280 + 64 * (j))
#define XB_XGEN(j)  (2304 + 64 * (j))
#define XB_TOP      3328
#define XB_TOPGEN   3392
#define XCD_BAR_WORDS 3456
#define XB_SPIN_CAP (1u << 18)

__device__ __forceinline__ unsigned xb_ld(unsigned* p)              { return __hip_atomic_load(p, __ATOMIC_RELAXED, __HIP_MEMORY_SCOPE_AGENT); }
__device__ __forceinline__ unsigned xb_add(unsigned* p, unsigned v) { return __hip_atomic_fetch_add(p, v, __ATOMIC_RELAXED, __HIP_MEMORY_SCOPE_AGENT); }
__device__ __forceinline__ unsigned xb_xcc_id() { return (unsigned)__builtin_amdgcn_s_getreg((3 << 11) | 20) & 0xFu; }
#define XB_SPIN(cond, bar) do { unsigned _sp = 0; while (cond) { __builtin_amdgcn_s_sleep(1); \
    if ((++_sp & 255u) == 0u) { if (xb_ld(&(bar)[XB_TMO])) break; if (_sp > XB_SPIN_CAP) { atomicAdd(&(bar)[XB_TMO], 1u); break; } } } } while (0)

struct XcdBarrier {
    unsigned* bar; unsigned x;
    volatile LAS unsigned* st;
};

__device__ __forceinline__ XcdBarrier xcd_barrier_post(unsigned* bar, volatile LAS unsigned* st) {
    XcdBarrier b; b.bar = bar; b.x = xb_xcc_id(); b.st = st;
    if (threadIdx.x == 0) (void)xb_add(&bar[XB_XCNT(b.x)], 1u);
    return b;
}
__device__ __forceinline__ void xcd_barrier_complete(unsigned* bar, unsigned x, unsigned& nloc, unsigned& nx) {
    const unsigned G = gridDim.x * gridDim.y * gridDim.z;
    unsigned sum, cnt, mine, sp = 0u;
    for (;;) {
        sum = 0u; cnt = 0u; mine = 0u;
#pragma unroll
        for (unsigned j = 0; j < 16; ++j) { const unsigned c = xb_ld(&bar[XB_XCNT(j)]); sum += c; cnt += (c > 0u) ? 1u : 0u; mine = (j == x) ? c : mine; }
        if (sum == G) break;
        __builtin_amdgcn_s_sleep(1);
        if ((++sp & 255u) == 0u) { if (xb_ld(&bar[XB_TMO])) break; if (sp > XB_SPIN_CAP) { atomicAdd(&bar[XB_TMO], 1u); break; } }
    }
    nloc = mine > 0u ? mine : 1u; nx = cnt > 0u ? cnt : 1u;
}

__device__ __forceinline__ void xcd_barrier(const XcdBarrier& b) {
    asm volatile("s_waitcnt vmcnt(0)" ::: "memory");
    __syncthreads();
    if (threadIdx.x == 0) {
        unsigned* bar = b.bar;
        __builtin_amdgcn_s_waitcnt(0);
        unsigned nloc = b.st[0], nx = b.st[1];
        if (nloc == 0u) { xcd_barrier_complete(bar, b.x, nloc, nx); b.st[0] = nloc; b.st[1] = nx; }
        const unsigned old = xb_add(&bar[XB_XSUB(b.x)], 1u);
        const unsigned gen = old / nloc;
        if (old + 1u == (gen + 1u) * nloc) {
            __builtin_amdgcn_fence(__ATOMIC_RELEASE, "agent");
            asm volatile("s_waitcnt vmcnt(0)" ::: "memory");
            const unsigned og = xb_add(&bar[XB_TOP], 1u);
            const unsigned tg = og / nx;
            if (og + 1u == (tg + 1u) * nx) xb_add(&bar[XB_TOPGEN], 1u);
            else XB_SPIN(xb_ld(&bar[XB_TOPGEN]) == tg, bar);
            __builtin_amdgcn_fence(__ATOMIC_ACQUIRE, "agent");
            xb_add(&bar[XB_XGEN(b.x)], 1u);
            asm volatile("s_waitcnt vmcnt(0)" ::: "memory");
        } else {
            XB_SPIN(xb_ld(&bar[XB_XGEN(b.x)]) == gen, bar);
            __builtin_amdgcn_fence(__ATOMIC_ACQUIRE, "agent");
            asm volatile("s_waitcnt vmcnt(0)" ::: "memory");
        }
    }
    __syncthreads();
}

__device__ __forceinline__ void transpose_item(const float* W, int K, int N, bf16* WT, int mode, const float* gk, LAS float* scr, int item, int lane) {
    const int nblk = N / 32, kb = item / nblk, nb = item % nblk, k0 = 64 * kb, n0 = 32 * nb;
    const GAS float* src = (const GAS float*)W + (size_t)k0 * N + n0 + (lane & 31);
    const float gl = gk ? gk[k0 + lane] : 1.0f;
#pragma unroll 8
    for (int i = 0; i < 32; ++i) { const int kk = 2 * i + (lane >> 5); scr[kk * 33 + (lane & 31)] = src[(size_t)kk * N] * __shfl(gl, kk); }
    LDS_WAIT(); asm volatile("" ::: "memory");
    const int c = lane & 7;
    const int rb = (mode == 0) ? n0 : ((n0 >> 7) * 256 + (n0 & 127) + (mode == 2 ? 128 : 0));
#pragma unroll
    for (int j = 0; j < 4; ++j) { const int n = (lane >> 3) + 8 * j; const LAS float* s = scr + (8 * c) * 33 + n;
        v4u o; o.x = pk2(s[0 * 33], s[1 * 33]); o.y = pk2(s[2 * 33], s[3 * 33]); o.z = pk2(s[4 * 33], s[5 * 33]); o.w = pk2(s[6 * 33], s[7 * 33]);
        *(GAS v4u*)(WT + (size_t)(rb + n) * K + k0 + 8 * c) = o; }
    LDS_WAIT(); asm volatile("" ::: "memory");
}
constexpr float WD8_SCALE = 64.0f;
__device__ __forceinline__ unsigned pk8x4(const LAS float* sp, int e) { int w = 0; w = __builtin_amdgcn_cvt_pk_fp8_f32(sp[(e + 0) * 33], sp[(e + 1) * 33], w, false); w = __builtin_amdgcn_cvt_pk_fp8_f32(sp[(e + 2) * 33], sp[(e + 3) * 33], w, true); return (unsigned)w; }
__device__ __forceinline__ void transpose_item_fp8(const float* W, int K, int N, unsigned char* WT8, float wscale, LAS float* scr, int item, int lane) {
    const int nblk = N / 32, kb = item / nblk, nb = item % nblk, k0 = 64 * kb, n0 = 32 * nb;
    const GAS float* src = (const GAS float*)W + (size_t)k0 * N + n0 + (lane & 31);
#pragma unroll 8
    for (int i = 0; i < 32; ++i) { const int kk = 2 * i + (lane >> 5); scr[kk * 33 + (lane & 31)] = src[(size_t)kk * N] * wscale; }
    LDS_WAIT(); asm volatile("" ::: "memory");
    const int n = lane >> 1, h = lane & 1; const LAS float* sp = scr + (32 * h) * 33 + n;
    v4u o0, o1;
    o0.x = pk8x4(sp, 0); o0.y = pk8x4(sp, 4); o0.z = pk8x4(sp, 8); o0.w = pk8x4(sp, 12); o1.x = pk8x4(sp, 16); o1.y = pk8x4(sp, 20); o1.z = pk8x4(sp, 24); o1.w = pk8x4(sp, 28);
    GAS v4u* dst = (GAS v4u*)(WT8 + (size_t)(n0 + n) * K + k0 + 32 * h); dst[0] = o0; dst[1] = o1;
    LDS_WAIT(); asm volatile("" ::: "memory");
}
template <int N> __device__ __forceinline__ void wht_inreg(float (&v)[N]) {
#pragma unroll
    for (int st = 1; st < N; st <<= 1)
#pragma unroll
        for (int i = 0; i < N; ++i) if (!(i & st)) { const float a = v[i], b = v[i + st]; v[i] = a + b; v[i + st] = a - b; }
}
template <int MASK> __device__ __forceinline__ float lane_xor(float v) {
    if constexpr (MASK == 1) return __builtin_bit_cast(float, __builtin_amdgcn_mov_dpp(__builtin_bit_cast(int, v), 0xB1  , 0xF, 0xF, true));
    else if constexpr (MASK == 2) return __builtin_bit_cast(float, __builtin_amdgcn_mov_dpp(__builtin_bit_cast(int, v), 0x4E  , 0xF, 0xF, true));
    else if constexpr (MASK == 4) return __builtin_bit_cast(float, __builtin_amdgcn_ds_swizzle(__builtin_bit_cast(int, v), 0x101F  ));
    else return __shfl_xor(v, MASK);
}
template <int N, int MASK> __device__ __forceinline__ void wht_xlane(float (&v)[N], bool upper) {
    const float sg = upper ? -1.0f : 1.0f;
#pragma unroll
    for (int i = 0; i < N; ++i) { const float o = lane_xor<MASK>(v[i]); v[i] = fmaf(v[i], sg, o); }
}
template <bool ROT>
__device__ __forceinline__ void absmax_item(const float* W, int K, int N, const float* gk, unsigned* scw, int item, int lane) {
    const int nblk = N / 32, kb = item / nblk, nb = item % nblk, k0 = 64 * kb, n0 = 32 * nb;
    const GAS float* src = (const GAS float*)W + (size_t)k0 * N + n0 + (lane & 31);
    const float gl = gk ? gk[k0 + lane] : 1.0f; float mx = 0.f;
    if (ROT) { float v[32];
#pragma unroll
        for (int i = 0; i < 32; ++i) { const int kk = 2 * i + (lane >> 5); v[i] = src[(size_t)kk * N] * __shfl(gl, kk); }
        wht_inreg<32>(v); wht_xlane<32, 32>(v, lane >= 32);
#pragma unroll
        for (int i = 0; i < 32; ++i) mx = fmaxf(mx, fabsf(v[i]));
    } else {
#pragma unroll 8
        for (int i = 0; i < 32; ++i) { const int kk = 2 * i + (lane >> 5); mx = fmaxf(mx, fabsf(src[(size_t)kk * N] * __shfl(gl, kk))); }
    }
    mx = fmaxf(mx, __shfl_xor(mx, 32));
    if (lane < 32) atomicMax(scw + n0 + lane, __float_as_uint(mx));
}
__device__ __forceinline__ unsigned pk4_i8(float a, float b, float c, float d) {
    const float MG = 12582912.0f; const unsigned ua = __float_as_uint(a + MG), ub = __float_as_uint(b + MG), uc = __float_as_uint(c + MG), ud = __float_as_uint(d + MG);
    return __builtin_amdgcn_perm(ub, ua, 0x0c0c0400u) | __builtin_amdgcn_perm(ud, uc, 0x04000c0cu); }
template <bool ROT>
__device__ __forceinline__ void transpose_item_i8(const float* W, int K, int N, unsigned char* WT8, int mode, const float* gk, const unsigned* scw, LAS float* scr, int item, int lane) {
    const int nblk = N / 32, kb = item / nblk, nb = item % nblk, k0 = 64 * kb, n0 = 32 * nb;
    const GAS float* src = (const GAS float*)W + (size_t)k0 * N + n0 + (lane & 31);
    const float gl = gk ? gk[k0 + lane] : 1.0f;
#pragma unroll 8
    for (int i = 0; i < 32; ++i) { const int kk = 2 * i + (lane >> 5); scr[kk * 33 + (lane & 31)] = src[(size_t)kk * N] * __shfl(gl, kk); }
    LDS_WAIT(); asm volatile("" ::: "memory");
    const int n = lane >> 1, h = lane & 1; const LAS float* sp = scr + (32 * h) * 33 + n;
    const float q = 127.0f / fmaxf(__uint_as_float(scw[n0 + n]), 1e-30f);
    const int rb = (mode == 0) ? n0 : ((n0 >> 7) * 256 + (n0 & 127) + (mode == 2 ? 128 : 0));
    float v[32];
#pragma unroll
    for (int e = 0; e < 32; ++e) v[e] = sp[e * 33];
    if (ROT) { wht_inreg<32>(v); wht_xlane<32, 1>(v, h != 0); }
    v4u o0, o1;
#define PK8(e) pk4_i8(v[(e) + 0] * q, v[(e) + 1] * q, v[(e) + 2] * q, v[(e) + 3] * q)
    o0.x = PK8(0); o0.y = PK8(4); o0.z = PK8(8); o0.w = PK8(12); o1.x = PK8(16); o1.y = PK8(20); o1.z = PK8(24); o1.w = PK8(28);
#undef PK8
    GAS v4u* dst = (GAS v4u*)(WT8 + (size_t)(rb + n) * K + k0 + 32 * h); dst[0] = o0; dst[1] = o1;
    LDS_WAIT(); asm volatile("" ::: "memory");
}
constexpr int I_GU = (DM / 64) * (FF / 32), I_D = (FF / 64) * (DM / 32), I_IN = (DM / 64) * (NPROJ / 32), I_OUT = (DM / 64) * (DM / 32);
template <bool DOWN_FP8>
__device__ __forceinline__ void convert_ffn_item(int r, const float* Wg, const float* Wu, const float* Wd, const float* gpre, bf16* WA, bf16* WD, LAS float* scr, int lane) {
    if (r < I_GU) { transpose_item(Wg, DM, FF, WA, 1, gpre, scr, r, lane); return; } r -= I_GU;
    if (r < I_GU) { transpose_item(Wu, DM, FF, WA, 2, gpre, scr, r, lane); return; } r -= I_GU;
    if (DOWN_FP8) transpose_item_fp8(Wd, FF, DM, (unsigned char*)WD, WD8_SCALE, scr, r, lane);
    else transpose_item(Wd, FF, DM, WD, 0, nullptr, scr, r, lane);
}

template <bool QOUT>
__device__ __forceinline__ void xb_row(const float* xrow, bf16* orow, float* rinv, int lane, unsigned char* xqrow) {
    const GAS f32x4* xr = (const GAS f32x4*)xrow + lane;
    f32x4 v[16]; float ss = 0.f;
#pragma unroll
    for (int j = 0; j < 16; ++j) { v[j] = xr[64 * j]; ss += (v[j].x * v[j].x + v[j].y * v[j].y) + (v[j].z * v[j].z + v[j].w * v[j].w); }
    GAS v2u* o8 = (GAS v2u*)orow + lane;
#pragma unroll
    for (int j = 0; j < 16; ++j) { v2u o; o.x = pk2(v[j].x, v[j].y); o.y = pk2(v[j].z, v[j].w); o8[64 * j] = o; }
    float r = 1.0f / sqrtf(wave_sum(ss) * (1.f / DM) + EPS);
    if (QOUT) { float mx = 0.f;
#pragma unroll
        for (int j = 0; j < 16; ++j) mx = fmaxf(fmaxf(mx, fmaxf(fabsf(v[j].x), fabsf(v[j].y))), fmaxf(fabsf(v[j].z), fabsf(v[j].w)));
#pragma unroll
        for (int o = 1; o < 64; o <<= 1) mx = fmaxf(mx, __shfl_xor(mx, o));
        mx = fmaxf(mx, 1e-30f); const float q = 127.0f / mx; GAS unsigned* o4 = (GAS unsigned*)xqrow + lane;
#pragma unroll
        for (int j = 0; j < 16; ++j) o4[64 * j] = pk4_i8(v[j].x * q, v[j].y * q, v[j].z * q, v[j].w * q);
        r *= mx * (1.0f / 127.0f); }
    if (lane == 0) *rinv = r;
}
template <bool FINAL, bool QOUT = false>
__device__ __forceinline__ void resid_row(bf16* xbrow, const bf16* yrow, const float* gpost, float s, float* outrow, float* rinv, int lane, unsigned char* xqrow = nullptr) {
    const GAS v2u* xr = (const GAS v2u*)xbrow + lane; const GAS v2u* yr = (const GAS v2u*)yrow + lane; const GAS f32x4* gp = (const GAS f32x4*)gpost + lane;
    v2u xw[16]; f32x4 v[16]; float ss = 0.f;
#pragma unroll
    for (int j = 0; j < 16; ++j) { xw[j] = xr[64 * j]; const v2u y = yr[64 * j]; v[j] = (f32x4){bflo(y.x), bfhi(y.x), bflo(y.y), bfhi(y.y)}; ss += (v[j].x * v[j].x + v[j].y * v[j].y) + (v[j].z * v[j].z + v[j].w * v[j].w); }
    const float ry = s / sqrtf(wave_sum(ss) * (1.f / DM) + EPS);
    float sx = 0.f;
#pragma unroll
    for (int j = 0; j < 16; ++j) { const f32x4 x = (f32x4){bflo(xw[j].x), bfhi(xw[j].x), bflo(xw[j].y), bfhi(xw[j].y)}, g = gp[64 * j]; v[j] = x + (v[j] * ry) * g;
        if (FINAL) ((GAS f32x4*)outrow + lane)[64 * j] = v[j];
        else { v2u o; o.x = pk2(v[j].x, v[j].y); o.y = pk2(v[j].z, v[j].w); ((GAS v2u*)xbrow + lane)[64 * j] = o; sx += (v[j].x * v[j].x + v[j].y * v[j].y) + (v[j].z * v[j].z + v[j].w * v[j].w); } }
    if (!FINAL) { float r = 1.0f / sqrtf(wave_sum(sx) * (1.f / DM) + EPS);
        if (QOUT) { float mx = 0.f;
#pragma unroll
            for (int j = 0; j < 16; ++j) mx = fmaxf(fmaxf(mx, fmaxf(fabsf(v[j].x), fabsf(v[j].y))), fmaxf(fabsf(v[j].z), fabsf(v[j].w)));
#pragma unroll
            for (int o = 1; o < 64; o <<= 1) mx = fmaxf(mx, __shfl_xor(mx, o));
            mx = fmaxf(mx, 1e-30f); const float q = 127.0f / mx; GAS unsigned* o4 = (GAS unsigned*)xqrow + lane;
#pragma unroll
            for (int j = 0; j < 16; ++j) o4[64 * j] = pk4_i8(v[j].x * q, v[j].y * q, v[j].z * q, v[j].w * q);
            r *= mx * (1.0f / 127.0f); }
        if (lane == 0) *rinv = r; }
}
__device__ __forceinline__ void unpack8(const v4u w, float (&f)[8]) { f[0] = bflo(w.x); f[1] = bfhi(w.x); f[2] = bflo(w.y); f[3] = bfhi(w.y); f[4] = bflo(w.z); f[5] = bfhi(w.z); f[6] = bflo(w.w); f[7] = bfhi(w.w); }
__device__ __forceinline__ void qk_prep_row(bf16* prow, bf16* krow, size_t kstride, int t, const float* qn, const float* kn, const float* rope, int lane, float qc) {
    const int hg = lane >> 3, c8 = lane & 7;
    const int pos = (c8 < 4) ? (t >> 6) : (t & 63), k0 = (c8 & 3) * 8;
    const GAS f32x4* rp = (const GAS f32x4*)(rope + (size_t)(pos * 32 + k0) * 2);
    const f32x4 r0 = rp[0], r1 = rp[1], r2 = rp[2], r3 = rp[3];
    const float cs[8] = {r0.x, r0.z, r1.x, r1.z, r2.x, r2.z, r3.x, r3.z}, sn[8] = {r0.y, r0.w, r1.y, r1.w, r2.y, r2.w, r3.y, r3.w};
    v4u av[3], bv[3];
#pragma unroll
    for (int p = 0; p < 3; ++p) { const int head = 8 * p + hg, hc = head < 20 ? head : 19; const GAS v4u* hp = (const GAS v4u*)(prow + hc * HD + 8 * c8); av[p] = hp[0]; bv[p] = hp[8]; }
#pragma unroll
    for (int p = 0; p < 3; ++p) {
        const int head = 8 * p + hg; const bool valid = head < 20; const int hc = valid ? head : 19;
        GAS v4u* hp = (hc < 16) ? (GAS v4u*)(prow + hc * HD + 8 * c8) : (GAS v4u*)(krow + (size_t)(hc - 16) * kstride + 8 * c8);
        float x1[8], x2[8]; unpack8(av[p], x1); unpack8(bv[p], x2);
        float ss = 0.f;
#pragma unroll
        for (int e = 0; e < 8; ++e) ss += x1[e] * x1[e] + x2[e] * x2[e];
        ss += __shfl_xor(ss, 1); ss += __shfl_xor(ss, 2); ss += __shfl_xor(ss, 4);
        const float rinv = (hc < 16 ? qc : 1.0f) / sqrtf(ss * (1.f / HD) + EPS);
        const GAS f32x4* gp = (const GAS f32x4*)((hc < 16 ? qn : kn) + 8 * c8);
        const f32x4 ga0 = gp[0], ga1 = gp[1], gb0 = gp[16], gb1 = gp[17];
        const float g1[8] = {ga0.x, ga0.y, ga0.z, ga0.w, ga1.x, ga1.y, ga1.z, ga1.w}, g2[8] = {gb0.x, gb0.y, gb0.z, gb0.w, gb1.x, gb1.y, gb1.z, gb1.w};
        float o1[8], o2[8];
#pragma unroll
        for (int e = 0; e < 8; ++e) { const float u1 = x1[e] * rinv * g1[e], u2 = x2[e] * rinv * g2[e]; o1[e] = u1 * cs[e] - u2 * sn[e]; o2[e] = u2 * cs[e] + u1 * sn[e]; }
        if (valid) { v4u wa, wb; wa.x = pk2(o1[0], o1[1]); wa.y = pk2(o1[2], o1[3]); wa.z = pk2(o1[4], o1[5]); wa.w = pk2(o1[6], o1[7]);
            wb.x = pk2(o2[0], o2[1]); wb.y = pk2(o2[2], o2[3]); wb.z = pk2(o2[4], o2[5]); wb.w = pk2(o2[6], o2[7]); hp[0] = wa; hp[8] = wb; }
    }
}
__device__ __forceinline__ void v_copy_row(const bf16* prow, bf16* vrow, size_t vstride, int lane) {
    const v4u w = *(const GAS v4u*)(prow + PO_V + 8 * lane);
    *(GAS v4u*)(vrow + (size_t)(lane >> 4) * vstride + 8 * (lane & 15)) = w;
}
__device__ __forceinline__ void vt_tile_item(const bf16* proj, bf16* vt, int item, int lane) {
    const int kvh = item & 3, tile = item >> 2;
    const int key = (lane & 32) | ((lane & 4) << 2) | ((lane & 24) >> 1) | (lane & 3);
    const GAS v4u* src = (const GAS v4u*)(proj + (size_t)(tile * 64 + key) * NPROJ + PO_V + kvh * HD);
    v4u w[16];
#pragma unroll
    for (int i = 0; i < 16; ++i) w[i] = src[i];
    GAS bf16* dst = (GAS bf16*)(vt + ((size_t)kvh * (M / 64) + tile) * (HD * 64) + lane);
#pragma unroll
    for (int i = 0; i < 16; ++i) { const unsigned u[4] = {w[i].x, w[i].y, w[i].z, w[i].w};
#pragma unroll
        for (int e = 0; e < 4; ++e) { dst[(8 * i + 2 * e) * 64] = (bf16)(u[e] & 0xffffu); dst[(8 * i + 2 * e + 1) * 64] = (bf16)(u[e] >> 16); } }
}
__device__ __forceinline__ void conv_row(const bf16* prow, bool has_prev, bool has_next, const float* cw, const float* gc, bf16* aorow, int lane) {
    const bf16* const pprev = has_prev ? prow - NPROJ : prow; const bf16* const pnext = has_next ? prow + NPROJ : prow;
    const float mp = has_prev ? 1.f : 0.f, mn = has_next ? 1.f : 0.f;
    v4u Bv[4], Cc[4], Hc[4], Cp[4], Hp[4], Cn[4], Hn[4];
#pragma unroll
    for (int q = 0; q < 4; ++q) { const int ch = 8 * (lane + 64 * q);
        Bv[q] = *(const GAS v4u*)(prow + PO_B + ch); Cc[q] = *(const GAS v4u*)(prow + PO_C + ch); Hc[q] = *(const GAS v4u*)(prow + PO_H + ch);
        Cp[q] = *(const GAS v4u*)(pprev + PO_C + ch); Hp[q] = *(const GAS v4u*)(pprev + PO_H + ch);
        Cn[q] = *(const GAS v4u*)(pnext + PO_C + ch); Hn[q] = *(const GAS v4u*)(pnext + PO_H + ch); }
    float y[4][8]; float ss = 0.f;
#pragma unroll
    for (int q = 0; q < 4; ++q) { const int ch = 8 * (lane + 64 * q);
        const GAS f32x4* w = (const GAS f32x4*)(cw + ch);
        const f32x4 w0a = w[0], w0b = w[1], w1a = w[CW / 4], w1b = w[CW / 4 + 1], w2a = w[2 * CW / 4], w2b = w[2 * CW / 4 + 1];
        const float w0[8] = {w0a.x, w0a.y, w0a.z, w0a.w, w0b.x, w0b.y, w0b.z, w0b.w}, w1[8] = {w1a.x, w1a.y, w1a.z, w1a.w, w1b.x, w1b.y, w1b.z, w1b.w}, w2[8] = {w2a.x, w2a.y, w2a.z, w2a.w, w2b.x, w2b.y, w2b.z, w2b.w};
        float fb[8], fc[8], fh[8], pc[8], ph[8], nc[8], nh[8]; unpack8(Bv[q], fb); unpack8(Cc[q], fc); unpack8(Hc[q], fh); unpack8(Cp[q], pc); unpack8(Hp[q], ph); unpack8(Cn[q], nc); unpack8(Hn[q], nh);
#pragma unroll
        for (int e = 0; e < 8; ++e) { const float v = fb[e] * (w0[e] * (pc[e] * ph[e] * mp) + w1[e] * (fc[e] * fh[e]) + w2[e] * (nc[e] * nh[e] * mn)); y[q][e] = v; ss += v * v; }
    }
    const float rinv = 1.0f / sqrtf(wave_sum(ss) * (1.f / CW) + EPS);
#pragma unroll
    for (int q = 0; q < 4; ++q) { const int ch = 8 * (lane + 64 * q); const GAS f32x4* g = (const GAS f32x4*)(gc + ch); const f32x4 ga = g[0], gb = g[1];
        v4u o; o.x = pk2(y[q][0] * rinv * ga.x, y[q][1] * rinv * ga.y); o.y = pk2(y[q][2] * rinv * ga.z, y[q][3] * rinv * ga.w); o.z = pk2(y[q][4] * rinv * gb.x, y[q][5] * rinv * gb.y); o.w = pk2(y[q][6] * rinv * gb.z, y[q][7] * rinv * gb.w);
        *(GAS v4u*)(aorow + AW + ch) = o; }
}
__device__ __forceinline__ void attn_norm_row(const bf16* orow, const float* ga, bf16* aorow, int lane) {
    float y[4][8]; float ss = 0.f;
#pragma unroll
    for (int q = 0; q < 4; ++q) { const v4u w = *(const GAS v4u*)(orow + 8 * (lane + 64 * q)); unpack8(w, y[q]);
#pragma unroll
        for (int e = 0; e < 8; ++e) ss += y[q][e] * y[q][e]; }
    const float rinv = 1.0f / sqrtf(wave_sum(ss) * (1.f / AW) + EPS);
#pragma unroll
    for (int q = 0; q < 4; ++q) { const int ch = 8 * (lane + 64 * q); const GAS f32x4* g = (const GAS f32x4*)(ga + ch); const f32x4 g0 = g[0], g1 = g[1];
        v4u o; o.x = pk2(y[q][0] * rinv * g0.x, y[q][1] * rinv * g0.y); o.y = pk2(y[q][2] * rinv * g0.z, y[q][3] * rinv * g0.w); o.z = pk2(y[q][4] * rinv * g1.x, y[q][5] * rinv * g1.y); o.w = pk2(y[q][6] * rinv * g1.z, y[q][7] * rinv * g1.w);
        *(GAS v4u*)(aorow + ch) = o; }
}
typedef _Float16 h2 __attribute__((ext_vector_type(2)));
__device__ __forceinline__ h2 as_h2(unsigned u) { return __builtin_bit_cast(h2, u); }
__device__ __forceinline__ unsigned as_u32(h2 v) { return __builtin_bit_cast(unsigned, v); }
typedef unsigned short us2 __attribute__((ext_vector_type(2)));
__device__ __forceinline__ us2 as_us2(unsigned u) { return __builtin_bit_cast(us2, u); }
__device__ __forceinline__ h2 h2_addsub(h2 a) { h2 d; asm("v_pk_add_f16 %0, %1, %1 op_sel:[0,1] op_sel_hi:[0,1] neg_hi:[0,1]" : "=v"(d) : "v"(a)); return d; }
template <int MASK> __device__ __forceinline__ h2 h2_xlane(h2 v, h2 sg) { const h2 o = as_h2(__float_as_uint(lane_xor<MASK>(__uint_as_float(as_u32(v))))); return v * sg + o; }
__device__ __forceinline__ void hquant_row(const bf16* hrow, unsigned char* hqrow, float* hs, int lane) {
    constexpr int NCH = FF / 8, NIT = (NCH + 63) / 64;
    const GAS v4u* hp = (const GAS v4u*)hrow + lane; v4u raw[NIT]; us2 mx2 = {0, 0};
    const h2 one = {(_Float16)1.f, (_Float16)1.f}, s1 = (lane & 1) ? -one : one, s2 = (lane & 2) ? -one : one, s4 = (lane & 4) ? -one : one;
#pragma unroll
    for (int i = 0; i < NIT; ++i) { const bool ok = lane + 64 * i < NCH; const v4u w = hp[ok ? 64 * i : 0];
        h2 r0 = as_h2(w.x), r1 = as_h2(w.y), r2 = as_h2(w.z), r3 = as_h2(w.w);
        r0 = h2_addsub(r0); r1 = h2_addsub(r1); r2 = h2_addsub(r2); r3 = h2_addsub(r3);
        { const h2 a = r0 + r1, b = r0 - r1, c = r2 + r3, d = r2 - r3; r0 = a; r1 = b; r2 = c; r3 = d; }
        { const h2 a = r0 + r2, b = r0 - r2, c = r1 + r3, d = r1 - r3; r0 = a; r2 = b; r1 = c; r3 = d; }
        r0 = h2_xlane<1>(r0, s1); r1 = h2_xlane<1>(r1, s1); r2 = h2_xlane<1>(r2, s1); r3 = h2_xlane<1>(r3, s1);
        r0 = h2_xlane<2>(r0, s2); r1 = h2_xlane<2>(r1, s2); r2 = h2_xlane<2>(r2, s2); r3 = h2_xlane<2>(r3, s2);
        r0 = h2_xlane<4>(r0, s4); r1 = h2_xlane<4>(r1, s4); r2 = h2_xlane<4>(r2, s4); r3 = h2_xlane<4>(r3, s4);
        raw[i].x = as_u32(r0); raw[i].y = as_u32(r1); raw[i].z = as_u32(r2); raw[i].w = as_u32(r3);
        const unsigned am = ok ? 0x7fff7fffu : 0u;
        mx2 = __builtin_elementwise_max(mx2, as_us2(raw[i].x & am)); mx2 = __builtin_elementwise_max(mx2, as_us2(raw[i].y & am));
        mx2 = __builtin_elementwise_max(mx2, as_us2(raw[i].z & am)); mx2 = __builtin_elementwise_max(mx2, as_us2(raw[i].w & am)); }
    const h2 mxh = as_h2(__builtin_bit_cast(unsigned, mx2)); const _Float16 mlo = mxh.x, mhi = mxh.y;
    float mx = fmaxf((float)mlo, (float)mhi);
#pragma unroll
    for (int o = 1; o < 64; o <<= 1) mx = fmaxf(mx, __shfl_xor(mx, o));
    const _Float16 q16 = (_Float16)fminf(127.0f / fmaxf(mx, 1e-30f), 32768.0f);
    const h2 q2 = {q16, q16}, mg = {(_Float16)1536.f, (_Float16)1536.f};
    GAS v2u* op = (GAS v2u*)hqrow + lane;
#pragma unroll
    for (int i = 0; i < NIT; ++i) {
        const unsigned t0 = as_u32(as_h2(raw[i].x) * q2 + mg), t1 = as_u32(as_h2(raw[i].y) * q2 + mg);
        const unsigned t2 = as_u32(as_h2(raw[i].z) * q2 + mg), t3 = as_u32(as_h2(raw[i].w) * q2 + mg);
        v2u o; o.x = __builtin_amdgcn_perm(t1, t0, 0x06040200u); o.y = __builtin_amdgcn_perm(t3, t2, 0x06040200u);
        if (lane + 64 * i < NCH) op[64 * i] = o; }
    if (lane == 0) *hs = 1.0f / (float)q16;
}
struct AttnUnit { int qrow0, krow0, seq, head; };
__device__ __forceinline__ bool attn_next(int G, int vcu, int i, AttnUnit& u) {
    if (G == 256) {
        if (i >= 8) return false;
        const int x = vcu >> 5, c = vcu & 31;
        if (i < 4) { const int kh = x & 3, hf = x >> 2, uu = hf * 128 + c * 4 + i, g = uu >> 6, qb = uu & 63;
            u.head = kh * 4 + g; u.krow0 = M_PROMPT; u.seq = S_SAMPLE; u.qrow0 = M_PROMPT + qb * 256; }
        else { const int j = (i - 4) >> 1, p = 2 * x + j, b = p >> 2, kh = p & 3, uu = c * 2 + ((i - 4) & 1), g = uu >> 4, qb = uu & 15;
            u.head = kh * 4 + g; u.krow0 = b * S_PROMPT; u.seq = S_PROMPT; u.qrow0 = b * S_PROMPT + qb * 256; }
        return true;
    }
    int L = i * G + vcu; if (L >= 2048) return false;
    if (L < 1024) { u.head = L >> 6; u.krow0 = M_PROMPT; u.seq = S_SAMPLE; u.qrow0 = M_PROMPT + (L & 63) * 256; }
    else { L -= 1024; const int b = L >> 8; u.head = (L >> 4) & 15; u.krow0 = b * S_PROMPT; u.seq = S_PROMPT; u.qrow0 = b * S_PROMPT + (L & 15) * 256; }
    return true;
}

#ifndef ATTN_MFMA16
#define ATTN_MFMA16 0
#endif
#ifndef ATTN_FAST
#define ATTN_FAST 1
#endif
#ifndef I8_GU1
#define I8_GU1 1
#endif
#ifndef I8_GU2
#define I8_GU2 1
#endif
#ifndef DOWN2_MODE
#define DOWN2_MODE 2
#endif
#define FP8_DOWN2 (DOWN2_MODE == 1)
#ifndef DOWN1_MODE
#define DOWN1_MODE 0
#endif
#if MK_PER_PHASE && DOWN1_MODE == 2
#error "the one-launch-per-phase debug build has no slot for the FFN1 h pass"
#endif
#ifndef PG8_SP2
#define PG8_SP2 true
#endif
#ifndef PG8_ALIGN
#define PG8_ALIGN true
#endif
#ifndef PG8_ALIGN_I8
#define PG8_ALIGN_I8 PG8_ALIGN
#endif
#ifndef ORDER_DOWN
#define ORDER_DOWN pg8::BlockOrder
#endif
#ifndef ORDER_GU
#define ORDER_GU pg8::StaticOrder
#endif
#ifndef ORDER_IO
#define ORDER_IO pg8::StaticOrder
#endif
#ifndef WGM_GU
#define WGM_GU 8
#endif
#ifndef WGM_DOWN
#define WGM_DOWN 2
#endif
struct Args { const float* in[21]; float* out; unsigned char* ws; int ph_lo, ph_hi; };
static_assert(sizeof(Args) == 21 * 8 + 8 + 8 + 8, "Args has no holes");
enum { IN_XP = 0, IN_XS, IN_F1PRE, IN_F1POST, IN_W1G, IN_W1U, IN_W1D, IN_MIXPRE, IN_MIXPOST, IN_WIN, IN_QN, IN_KN, IN_CONVW, IN_AON, IN_CON, IN_WOUT, IN_F2PRE, IN_F2POST, IN_W2G, IN_W2U, IN_W2D };

__device__ __forceinline__ bool attn_scores_bounded(const float* qn, const float* kn, int lane) {
    float gq = fmaxf(fabsf(qn[lane]), fabsf(qn[lane + 64])), gk = fmaxf(fabsf(kn[lane]), fabsf(kn[lane + 64]));
#pragma unroll
    for (int o = 1; o < 64; o <<= 1) { gq = fmaxf(gq, __shfl_xor(gq, o)); gk = fmaxf(gk, __shfl_xor(gk, o)); }
    return __builtin_amdgcn_readfirstlane((int)(128.0f * attn::QC * 1.02f * gq * gk <= 64.0f)) != 0;
}
__global__ void __launch_bounds__(NWAVES * 64, 2) hymba_fwd(Args args) {
    extern __shared__ __attribute__((aligned(16))) unsigned char lds[];
    LAS unsigned char* const L = (LAS unsigned char*)lds;
    volatile LAS unsigned* const MISC = (volatile LAS unsigned*)(L + MISC_OFF);
    const int tid = threadIdx.x, lane = tid & 63, wave = __builtin_amdgcn_readfirstlane(tid >> 6);
    const int G = gridDim.x, bx = blockIdx.x, vcu = (G % 8 == 0) ? (bx % 8) * (G / 8) + bx / 8 : bx;
    const int gw = vcu * NWAVES + wave, NGW = G * NWAVES;
    unsigned char* const ws = args.ws;
    unsigned* const ctl = (unsigned*)(ws + WS_CTL);
    float* const rope = (float*)(ws + WS_ROPE);
    bf16* const WA = (bf16*)(ws + WS_WA); bf16* const WD = (bf16*)(ws + WS_WD); bf16* const WIN = (bf16*)(ws + WS_WIN); bf16* const WOUT = (bf16*)(ws + WS_WOUT);
    bf16* const XB = (bf16*)(ws + WS_XN); float* const RINV = (float*)(ws + WS_RINV); unsigned* const scw = ctl + CW_SCW; unsigned* const scw1 = ctl + CW_SCW1; unsigned char* const XQ = (unsigned char*)args.out; unsigned char* const WQ = (unsigned char*)(ws + WS_WA); unsigned char* const HQ = (unsigned char*)args.out;     bf16* const Y = (bf16*)(ws + WS_Y); bf16* const H = (bf16*)(ws + WS_H); bf16* const PROJ = H; bf16* const OB = Y; bf16* const AO = (bf16*)args.out;
    bf16* const KC = (bf16*)(ws + WS_KC); bf16* const VC = (bf16*)(ws + WS_VC);
    float* const out = args.out;
    for (int u = tid; u < (LDS_BYTES - MISC_OFF) / 4; u += NWAVES * 64) ((LAS unsigned*)(L + MISC_OFF))[u] = 0u;
    __syncthreads();
#if MK_PER_PHASE
#define GRID_BAR() do { } while (0)
#else
    XcdBarrier bar = xcd_barrier_post(ctl + CW_BAR, MISC + 8);
#ifdef PROBE_BARWAIT
    unsigned long long bw_ = 0ull;
    int bwi_ = 0;
#define GRID_BAR() do { const unsigned long long b0_ = __builtin_amdgcn_s_memrealtime(); xcd_barrier(bar); if (((PROBE_BARWAIT) >> bwi_) & 1) bw_ += __builtin_amdgcn_s_memrealtime() - b0_; ++bwi_; } while (0)
#else
#define GRID_BAR() xcd_barrier(bar)
#endif
#endif
    const int lo = args.ph_lo, hi = args.ph_hi;
#define REPEAT(k)
#ifdef PROBE_SPIN_MASK
    unsigned long long tph_ = __builtin_amdgcn_s_memrealtime();
#define PHASE_END(k) do { if ((PROBE_SPIN_MASK >> (k)) & 1) { if (bx == 0 && tid == 0) { const unsigned long long t1_ = __builtin_amdgcn_s_memrealtime(), d_ = t1_ - tph_; \
        while (__builtin_amdgcn_s_memrealtime() - t1_ < d_) __builtin_amdgcn_s_sleep(8); } GRID_BAR(); } tph_ = __builtin_amdgcn_s_memrealtime(); } while (0)
#else
#define PHASE_END(k) do { } while (0)
#endif
#define IN(k) (lo <= (k) && (k) < hi)
#define XROW(m) ((m) < M_PROMPT ? args.in[IN_XP] + (size_t)(m) * DM : args.in[IN_XS] + (size_t)((m) - M_PROMPT) * DM)
    LAS float* const scr = (LAS float*)(L + RING_OFF + wave * 16384);

    if (IN(0)) { REPEAT(0) {
        constexpr int NITEMS = 3 * I_GU + I_IN + I_OUT;
        for (int it = gw; it < NITEMS; it += NGW) {
            int r = it;
#if I8_GU1
            if (r < I_GU) { absmax_item<false>(args.in[IN_W1G], DM, FF, args.in[IN_F1PRE], scw1, r, lane); continue; }
            if (r < 2 * I_GU) { absmax_item<false>(args.in[IN_W1U], DM, FF, args.in[IN_F1PRE], scw1 + FF, r - I_GU, lane); continue; }
#endif
#if DOWN1_MODE == 2
            if (r >= 2 * I_GU && r < 3 * I_GU) { absmax_item<true>(args.in[IN_W1D], FF, DM, nullptr, ctl + CW_SCW1D, r - 2 * I_GU, lane); continue; }
#endif
            if (r < 3 * I_GU) { if (!I8_GU1 || r >= 2 * I_GU) convert_ffn_item<false>(r, args.in[IN_W1G], args.in[IN_W1U], args.in[IN_W1D], args.in[IN_F1PRE], WA, WD, scr, lane); continue; } r -= 3 * I_GU;
            if (r < I_IN) { transpose_item(args.in[IN_WIN], DM, NPROJ, WIN, 0, args.in[IN_MIXPRE], scr, r, lane); continue; } r -= I_IN;
            transpose_item(args.in[IN_WOUT], DM, DM, WOUT, 0, nullptr, scr, r, lane);
        }
        for (int idx = bx * (NWAVES * 64) + tid; idx < 256 * 32; idx += G * NWAVES * 64) {
            const int pos = idx >> 5, k = idx & 31; const float inv = exp2f(-(float)k * (13.287712379549449f / 32.f)), ang = (float)pos * inv;
            rope[2 * idx] = cosf(ang); rope[2 * idx + 1] = sinf(ang); }
        for (int m = gw; m < M; m += NGW) xb_row<I8_GU1 != 0>(XROW(m), XB + (size_t)m * DM, RINV + m, lane, XQ + (size_t)m * DM);
        }
        GRID_BAR();
        PHASE_END(0);
    }
    if (IN(1)) {
#if I8_GU1
        for (int it = gw; it < 2 * I_GU; it += NGW) {
            if (it < I_GU) transpose_item_i8<false>(args.in[IN_W1G], DM, FF, WQ, 1, args.in[IN_F1PRE], scw1, scr, it, lane);
            else transpose_item_i8<false>(args.in[IN_W1U], DM, FF, WQ, 2, args.in[IN_F1PRE], scw1 + FF, scr, it - I_GU, lane);
        }
#endif
#if DOWN1_MODE == 2
        for (int it = gw; it < I_GU; it += NGW) transpose_item_i8<true>(args.in[IN_W1D], FF, DM, (unsigned char*)WD, 0, nullptr, ctl + CW_SCW1D, scr, it, lane);
#endif
#if I8_GU1 || DOWN1_MODE == 2
        GRID_BAR();
#endif
        PHASE_END(1);
    }
    if (IN(2)) {
        pg8::Gemm g{I8_GU1 ? (const bf16*)XQ : XB, I8_GU1 ? (const bf16*)WQ : WA, M, 2 * FF, I8_GU1 ? DM / 2 : DM};     ORDER_GU S; S.init(M, 2 * FF, G, bx, WGM_GU);
        pg8::EpiSwiGLU<false, I8_GU1 != 0, DOWN1_MODE == 2> E{H, FF, RINV, (const float*)scw1, FF};
        REPEAT(2) {
            pg8::gemm_phase<pg8::EpiSwiGLU<false, I8_GU1 != 0, DOWN1_MODE == 2>, ORDER_GU, PG8_ALIGN_I8, PG8_SP2, I8_GU1 ? 2 : 0>(L + RING_OFF, g, S, E); __syncthreads(); }
        GRID_BAR();
        PHASE_END(2);
    }
    if (IN(3)) {
#if DOWN1_MODE == 2
        for (int m = gw; m < M; m += NGW) hquant_row(H + (size_t)m * FF, HQ + (size_t)m * FF, RINV + m, lane);
        GRID_BAR();
#endif
        pg8::Gemm g{DOWN1_MODE == 2 ? (const bf16*)HQ : H, WD, M, DM, DOWN1_MODE ? FF / 2 : FF};   ORDER_DOWN S; S.init(M, DM, G, bx, WGM_DOWN);
        pg8::EpiBf16T<DOWN1_MODE == 2> E{Y, DM, DOWN1_MODE == 2 ? RINV : nullptr, DOWN1_MODE == 2 ? 1.0f / (127.0f * 64.0f) : 1.0f, (const float*)(ctl + CW_SCW1D)};
        REPEAT(3) {
            pg8::gemm_phase<pg8::EpiBf16T<DOWN1_MODE == 2>, ORDER_DOWN, PG8_ALIGN, PG8_SP2, DOWN1_MODE>(L + RING_OFF, g, S, E); __syncthreads(); }
        GRID_BAR();
        PHASE_END(3);
    }
    if (IN(4)) { REPEAT(4) {
        for (int m = gw; m < M; m += NGW) resid_row<false>(XB + (size_t)m * DM, Y + (size_t)m * DM, args.in[IN_F1POST], 0.5f, nullptr, RINV + m, lane);
#if I8_GU2
        for (int it = gw; it < 3 * I_GU; it += NGW) {
            if (it < I_GU) absmax_item<false>(args.in[IN_W2G], DM, FF, args.in[IN_F2PRE], scw, it, lane);
            else if (it < 2 * I_GU) absmax_item<false>(args.in[IN_W2U], DM, FF, args.in[IN_F2PRE], scw + FF, it - I_GU, lane);
            else if (DOWN2_MODE == 2) absmax_item<true>(args.in[IN_W2D], FF, DM, nullptr, ctl + CW_SCW2, it - 2 * I_GU, lane);
            else convert_ffn_item<FP8_DOWN2 != 0>(it, args.in[IN_W2G], args.in[IN_W2U], args.in[IN_W2D], args.in[IN_F2PRE], WA, WD, scr, lane);
        }
#else
        for (int it = gw; it < 3 * I_GU; it += NGW) convert_ffn_item<FP8_DOWN2 != 0>(it, args.in[IN_W2G], args.in[IN_W2U], args.in[IN_W2D], args.in[IN_F2PRE], WA, WD, scr, lane);
#endif
        }
        GRID_BAR();
        PHASE_END(4);
    }
    if (IN(5)) {
        pg8::Gemm g{XB, WIN, M, NPROJ, DM}; ORDER_IO S; S.init(M, NPROJ, G, bx);
        pg8::EpiBf16 E{PROJ, NPROJ, RINV, 1.0f, nullptr};
        REPEAT(5) {
            pg8::gemm_phase<pg8::EpiBf16, ORDER_IO, PG8_ALIGN, PG8_SP2>(L + RING_OFF, g, S, E); __syncthreads(); }
        GRID_BAR();
        PHASE_END(5);
    }
    if (IN(6)) {
        const bool fast16 = ATTN_FAST && ATTN_MFMA16 && attn::QPRE && attn_scores_bounded(args.in[IN_QN], args.in[IN_KN], lane);
        for (int m = gw; m < M; m += NGW) {
            const int t = m < M_PROMPT ? (m & (S_PROMPT - 1)) : m - M_PROMPT, S = m < M_PROMPT ? S_PROMPT : S_SAMPLE;
            conv_row(PROJ + (size_t)m * NPROJ, t > 0, t < S - 1, args.in[IN_CONVW], args.in[IN_CON], AO + (size_t)m * DM, lane);
        }
        VM_WAIT(); __syncthreads();
        for (int m = gw; m < M; m += NGW) {
            const int t = m < M_PROMPT ? (m & (S_PROMPT - 1)) : m - M_PROMPT;
            qk_prep_row(PROJ + (size_t)m * NPROJ, KC + (size_t)m * HD, (size_t)M * HD, t, args.in[IN_QN], args.in[IN_KN], rope, lane, attn::QPRE ? attn::QC : 1.0f);
            if (!fast16) v_copy_row(PROJ + (size_t)m * NPROJ, VC + (size_t)m * HD, (size_t)M * HD, lane);
        }
        if (fast16) for (int it = gw; it < (M / 64) * 4; it += NGW) vt_tile_item(PROJ, VC, it, lane);
#if I8_GU2
        for (int it = gw; it < 2 * I_GU; it += NGW) {
            if (it < I_GU) transpose_item_i8<false>(args.in[IN_W2G], DM, FF, WQ, 1, args.in[IN_F2PRE], scw, scr, it, lane);
            else transpose_item_i8<false>(args.in[IN_W2U], DM, FF, WQ, 2, args.in[IN_F2PRE], scw + FF, scr, it - I_GU, lane);
        }
#endif
#if I8_GU2 && DOWN2_MODE == 2
        for (int it = gw; it < I_GU; it += NGW) transpose_item_i8<true>(args.in[IN_W2D], FF, DM, (unsigned char*)WD, 0, nullptr, ctl + CW_SCW2, scr, it, lane);
#endif
        GRID_BAR();
        PHASE_END(6);
    }
    if (IN(7)) {
#ifdef PROBE_IDLE_TICKS
        { const unsigned long long t1_ = __builtin_amdgcn_s_memrealtime(); while (__builtin_amdgcn_s_memrealtime() - t1_ < (unsigned long long)(PROBE_IDLE_TICKS)) __builtin_amdgcn_s_sleep(16); }
#endif
        const bool fast = ATTN_FAST && attn::QPRE && attn_scores_bounded(args.in[IN_QN], args.in[IN_KN], lane), fast16 = fast && ATTN_MFMA16;
        AttnUnit u;
        REPEAT(7)
        for (int i = 0; attn_next(G, vcu, i, u); ++i) {
            const int kvh = u.head >> 2;
            const bf16* const qp = PROJ + (size_t)u.qrow0 * NPROJ + PO_Q + u.head * HD; const bf16* const kp = KC + ((size_t)kvh * M + u.krow0) * HD; const bf16* const vp = VC + ((size_t)kvh * M + u.krow0) * HD;
            bf16* const op = OB + (size_t)u.qrow0 * AW + u.head * HD;
#ifdef PROBE_PP_T
#define PP_TACC , (unsigned long long*)(ctl + 768)
#else
#define PP_TACC
#endif
            if (fast16) attn::attn_pp16_body(qp, kp, VC + ((size_t)kvh * (M / 64) + u.krow0 / 64) * (HD * 64), op, u.seq, (char*)lds + RING_OFF);
            else if (fast) attn::attn_pp_body<true>(qp, kp, vp, op, u.seq, (char*)lds + RING_OFF PP_TACC);
            else attn::attn_pp_body<false>(qp, kp, vp, op, u.seq, (char*)lds + RING_OFF PP_TACC);
#undef PP_TACC
            __syncthreads();
        }
        GRID_BAR();
        PHASE_END(7);
    }
    if (IN(8)) {
        REPEAT(8)
        for (int m = gw; m < M; m += NGW) attn_norm_row(OB + (size_t)m * AW, args.in[IN_AON], AO + (size_t)m * DM, lane);
        GRID_BAR();
        PHASE_END(8);
    }
    if (IN(9)) {
        pg8::Gemm g{AO, WOUT, M, DM, DM}; ORDER_IO S; S.init(M, DM, G, bx);
        pg8::EpiBf16 E{Y, DM, nullptr, 1.0f, nullptr};
        REPEAT(9) {
            pg8::gemm_phase<pg8::EpiBf16, ORDER_IO, PG8_ALIGN, PG8_SP2>(L + RING_OFF, g, S, E); __syncthreads(); }
        GRID_BAR();
        PHASE_END(9);
    }
    if (IN(10)) {
        for (int m = gw; m < M; m += NGW) resid_row<false, I8_GU2 != 0>(XB + (size_t)m * DM, Y + (size_t)m * DM, args.in[IN_MIXPOST], 1.0f, nullptr, RINV + m, lane, XQ + (size_t)m * DM);
        GRID_BAR();
        PHASE_END(10);
    }
    if (IN(11)) {
        pg8::Gemm g{I8_GU2 ? (const bf16*)XQ : XB, I8_GU2 ? (const bf16*)WQ : WA, M, 2 * FF, I8_GU2 ? DM / 2 : DM};     ORDER_GU S; S.init(M, 2 * FF, G, bx, WGM_GU);
        pg8::EpiSwiGLU<DOWN2_MODE == 1, I8_GU2 != 0, DOWN2_MODE == 2> E{H, FF, RINV, (const float*)scw, FF};
        REPEAT(11) {
            pg8::gemm_phase<pg8::EpiSwiGLU<DOWN2_MODE == 1, I8_GU2 != 0, DOWN2_MODE == 2>, ORDER_GU, PG8_ALIGN_I8, PG8_SP2, I8_GU2 ? 2 : 0>(L + RING_OFF, g, S, E); __syncthreads(); }
        GRID_BAR();
        PHASE_END(11);
    }
    if (IN(12)) {
#if DOWN2_MODE == 2
        for (int m = gw; m < M; m += NGW) hquant_row(H + (size_t)m * FF, HQ + (size_t)m * FF, RINV + m, lane);
        GRID_BAR();
#endif
        PHASE_END(12);
    }
    if (IN(13)) {
        pg8::Gemm g{DOWN2_MODE == 2 ? (const bf16*)HQ : H, WD, M, DM, DOWN2_MODE ? FF / 2 : FF};   ORDER_DOWN S; S.init(M, DM, G, bx, WGM_DOWN);
        pg8::EpiBf16T<DOWN2_MODE == 2> E{Y, DM, DOWN2_MODE == 2 ? RINV : nullptr, DOWN2_MODE == 1 ? 1.0f / WD8_SCALE : (DOWN2_MODE == 2 ? 1.0f / (127.0f * 64.0f) : 1.0f), (const float*)(ctl + CW_SCW2)};
        REPEAT(13) {
            pg8::gemm_phase<pg8::EpiBf16T<DOWN2_MODE == 2>, ORDER_DOWN, PG8_ALIGN, PG8_SP2, DOWN2_MODE>(L + RING_OFF, g, S, E); __syncthreads(); }
        GRID_BAR();
        PHASE_END(13);
    }
    if (IN(14)) {
        for (int m = gw; m < M; m += NGW) resid_row<true>(XB + (size_t)m * DM, Y + (size_t)m * DM, args.in[IN_F2POST], 0.5f, out + (size_t)m * DM, nullptr, lane);
#ifdef PROBE_SPIN_MASK
        GRID_BAR(); PHASE_END(14);
#endif
    }
#ifdef PROBE_PP_T
    if (bx == 0 && tid == 0) { const unsigned long long d_ = ((unsigned long long*)(ctl + 768))[PROBE_PP_T] >> 4, t1_ = __builtin_amdgcn_s_memrealtime();
        while (__builtin_amdgcn_s_memrealtime() - t1_ < d_) __builtin_amdgcn_s_sleep(8); }
#endif
#ifdef PROBE_BARWAIT
    GRID_BAR();
    if (tid == 0) atomicAdd(ctl + 512, (unsigned)bw_);
    xcd_barrier(bar);
    if (bx == 0 && tid == 0) { const unsigned long long d_ = (unsigned long long)(__hip_atomic_load(ctl + 512, __ATOMIC_RELAXED, __HIP_MEMORY_SCOPE_AGENT) / (unsigned)G), t1_ = __builtin_amdgcn_s_memrealtime();
        while (__builtin_amdgcn_s_memrealtime() - t1_ < d_) __builtin_amdgcn_s_sleep(8); }
#endif
#undef IN
#undef REPEAT
#undef PHASE_END
#undef XROW
#undef GRID_BAR
}

extern "C" void kernel_launch(void* const* d_in, const int* in_sizes, int n_in, void* d_out, int out_size, void* d_ws, size_t ws_size, hipStream_t stream) {
    static int grid = 0;
    if (grid == 0) {
        if (n_in != 21 || in_sizes[0] != M_PROMPT * DM || in_sizes[1] != M_SAMPLE * DM || out_size != M * DM || ws_size < WS_END) {
            fprintf(stderr, "kernel_launch: shape mismatch (n_in %d, out %d, ws %zu < %zu?); nothing launched\n", n_in, out_size, ws_size, (size_t)WS_END); grid = -1; return; }
        int dev = 0, cus = 0;
        if (hipGetDevice(&dev) != hipSuccess || hipDeviceGetAttribute(&cus, hipDeviceAttributeMultiprocessorCount, dev) != hipSuccess) { grid = -1; return; }
        if (hipFuncSetAttribute((const void*)hymba_fwd, hipFuncAttributeMaxDynamicSharedMemorySize, LDS_BYTES) != hipSuccess) { fprintf(stderr, "kernel_launch: hipFuncSetAttribute failed\n"); grid = -1; return; }
        int per_cu = 0;
        if (hipOccupancyMaxActiveBlocksPerMultiprocessor(&per_cu, (const void*)hymba_fwd, NWAVES * 64, LDS_BYTES) != hipSuccess || per_cu < 1)
            fprintf(stderr, "kernel_launch: note: occupancy query reports %d workgroups per CU\n", per_cu);
        (void)hipGetLastError();
        grid = cus;
#ifdef FORCE_GRID
        grid = FORCE_GRID;
#endif
    }
    if (grid < 0) return;
    if (hipMemsetAsync((char*)d_ws + WS_CTL, 0, CTL_ZERO_BYTES, stream) != hipSuccess) return;
    Args a{};
    for (int i = 0; i < 21; ++i) a.in[i] = (const float*)d_in[i];
    a.out = (float*)d_out; a.ws = (unsigned char*)d_ws;
#if MK_PER_PHASE
#ifndef PROBE_REPS
#define PROBE_REPS(k) 1
#endif
    for (int p = 0; p < N_PHASES; ++p) for (int r = 0; r < PROBE_REPS(p); ++r) { a.ph_lo = p; a.ph_hi = p + 1; hipLaunchKernelGGL(hymba_fwd, dim3(grid), dim3(NWAVES * 64), LDS_BYTES, stream, a); }
#else
    a.ph_lo = 0; a.ph_hi = N_PHASES;
    hipLaunchKernelGGL(hymba_fwd, dim3(grid), dim3(NWAVES * 64), LDS_BYTES, stream, a);
#endif
    const hipError_t le = hipPeekAtLastError();
    if (le != hipSuccess) fprintf(stderr, "kernel_launch: launch failed: %s\n", hipGetErrorName(le));
}
```

```cpp
#include <hip/hip_runtime.h>
#include <cstdio>
#include <cstdint>
namespace pg8 {
#define PG8_LAS __attribute__((address_space(3)))
typedef unsigned short bf16_t;
typedef short bf16x8 __attribute__((ext_vector_type(8)));
typedef float f32x4 __attribute__((ext_vector_type(4)));
typedef unsigned u32x4 __attribute__((ext_vector_type(4)));
constexpr int BM = 256, BK = 64, HALF = 128, HTB = HALF * BK * 2  , STAGE_BYTES = 8 * HTB, NXCD = 8, WGM = 8;

__host__ __device__ __forceinline__ int lds_byte(int r, int c) { const int st = (r >> 4) * 2 + (c >> 5), rr = r & 15, cc = c & 31, ob = rr * 64 + cc * 2; return st * 1024 + (ob ^ (((ob >> 9) & 1) << 5)); }
__host__ __device__ __forceinline__ void stage_rc(int b, int& R, int& C) { const int st = b / 1024, sb = b % 1024, swz = sb ^ (((sb >> 9) & 1) << 5); R = (st >> 1) * 16 + swz / 64; C = (st & 1) * 32 + (swz % 64) / 2; }
__host__ __device__ __forceinline__ int perm32(int rho) { const int n = rho >> 4, i = rho & 15; return 8 * (i >> 2) + 4 * n + (i & 3); }

struct Unit { int pm, pn; };
struct Gemm { const bf16_t* A; const bf16_t* Bt; int M, N, K; };

struct StaticOrder {
    int nM, nN, nwg, G, c, wgm;
    __host__ __device__ void init(int M, int N, int G_, int c_, int wgm_ = WGM) { nM = M / BM; nN = N / BM; nwg = nM * nN; G = G_; c = c_; wgm = wgm_; }
    __host__ __device__ bool next(int i, Unit& u) const {
        const long L = (long)i * G + c; if (L >= nwg) return false;
        int wgid = (int)L; { const int q = nwg / NXCD, r = nwg % NXCD, xcd = wgid % NXCD, off = wgid / NXCD; wgid = (xcd < r ? xcd * (q + 1) : r * (q + 1) + (xcd - r) * q) + off; }
        const int nig = wgm * nN, gid = wgid / nig, fm = gid * wgm, gsz = (nM - fm) < wgm ? (nM - fm) : wgm;
        u.pm = fm + ((wgid % nig) % gsz); u.pn = (wgid % nig) / gsz; return true;
    }
    __device__ __forceinline__ void a_ready(const Unit&) const {}
    __device__ __forceinline__ void done(const Unit&) const {}
};
struct BlockOrder : StaticOrder {
    __host__ __device__ bool next(int i, Unit& u) const {
        if (G != 256 || nM != 128 || (nN & 1)) return StaticOrder::next(i, u);
        const int x = c & 7, l = c >> 3, nb16 = nN >> 4, nmain = 8 * nb16;
        if (i < nmain) { const int band = i / nb16, cb = i - band * nb16; u.pm = 16 * band + 4 * (x >> 1) + (l & 3); u.pn = 16 * cb + 8 * (x & 1) + (l >> 2); return true; }
        int r = i - nmain, c0 = nb16 * 16, rem = nN - c0;
        if (rem >= 8) { if (r < 4) { u.pm = 32 * r + 8 * (x >> 1) + (l & 7); u.pn = c0 + 4 * (x & 1) + (l >> 3); return true; } r -= 4; c0 += 8; rem -= 8; }
        if (rem >= 4) { if (r < 2) { u.pm = 64 * r + 8 * x + (l & 7); u.pn = c0 + (l >> 3); return true; } r -= 2; c0 += 4; rem -= 4; }
        if (rem >= 2) { if (r < 1) { u.pm = 16 * x + (l & 15); u.pn = c0 + (l >> 4); return true; } }
        return false;
    }
};

typedef int v8i32 __attribute__((ext_vector_type(8)));
typedef int v4i32 __attribute__((ext_vector_type(4)));
__device__ __forceinline__ v8i32 cat8(bf16x8 lo, bf16x8 hi) { return __builtin_bit_cast(v8i32, __builtin_shufflevector(lo, hi, 0, 1, 2, 3, 4, 5, 6, 7, 8, 9, 10, 11, 12, 13, 14, 15)); }
__device__ __forceinline__ unsigned pk4_fp8(float a, float b, float c, float d) { int w = 0; w = __builtin_amdgcn_cvt_pk_fp8_f32(a, b, w, false); w = __builtin_amdgcn_cvt_pk_fp8_f32(c, d, w, true); return (unsigned)w; }
__device__ __forceinline__ unsigned cvt_pk_bf16(float lo, float hi) { unsigned r; asm volatile("v_cvt_pk_bf16_f32 %0, %1, %2" : "=v"(r) : "v"(lo), "v"(hi)); return r; }

template <bool I8> struct EpiBf16T {
    static constexpr bool PERM = true, AFTER_DRAIN = false;
    bf16_t* O; int ldc; const float* rs; float cs; const float* cw;
    __device__ __forceinline__ void operator()(const f32x4 (&acc)[2][2][4][2], const Unit& u, int wr, int wc, int fr, int fq) const {
        const int row0 = u.pm * BM + wr * 64 + fr, col0 = u.pn * BM + wc * 32 + 8 * fq;
        f32x4 wv[2][2];
        if constexpr (I8) {
#pragma unroll
            for (int bj = 0; bj < 2; ++bj) { wv[bj][0] = *(const f32x4*)(cw + col0 + bj * HALF); wv[bj][1] = *(const f32x4*)(cw + col0 + bj * HALF + 4); } }
#pragma unroll
        for (int ai = 0; ai < 2; ++ai)
#pragma unroll
            for (int m = 0; m < 4; ++m) { const int row = row0 + ai * HALF + m * 16; bf16_t* rowp = O + (size_t)row * ldc + col0; const float sc = rs ? rs[row] * cs : cs;
#pragma unroll
                for (int bj = 0; bj < 2; ++bj) { f32x4 v0, v1;
                    if constexpr (I8) { v0 = __builtin_convertvector(__builtin_bit_cast(v4i32, acc[ai][bj][m][0]), f32x4) * wv[bj][0] * sc; v1 = __builtin_convertvector(__builtin_bit_cast(v4i32, acc[ai][bj][m][1]), f32x4) * wv[bj][1] * sc; }
                    else { v0 = acc[ai][bj][m][0] * sc; v1 = acc[ai][bj][m][1] * sc; }
                    u32x4 w; w.x = cvt_pk_bf16(v0[0], v0[1]); w.y = cvt_pk_bf16(v0[2], v0[3]); w.z = cvt_pk_bf16(v1[0], v1[1]); w.w = cvt_pk_bf16(v1[2], v1[3]);
                    *(u32x4*)(rowp + bj * HALF) = w; } }
    }
};
typedef EpiBf16T<false> EpiBf16;
__device__ __forceinline__ float silu_mul(float g, float u) { return g * u * __builtin_amdgcn_rcpf(1.0f + __builtin_amdgcn_exp2f(-1.4426950408889634f * g)); }
__device__ __forceinline__ unsigned cvt_pk_f16(float lo, float hi) { return __builtin_bit_cast(unsigned, __builtin_amdgcn_cvt_pkrtz(lo, hi)); }
template <bool F8  , bool I8 = false  , bool H16 = false  > struct EpiSwiGLU {
    static constexpr bool PERM = true, AFTER_DRAIN = false;
    bf16_t* O; int ldc; const float* rs; const float* cw; int cup;
    __device__ __forceinline__ void operator()(const f32x4 (&acc)[2][2][4][2], const Unit& u, int wr, int wc, int fr, int fq) const {
        const int row0 = u.pm * BM + wr * 64 + fr, col0 = u.pn * HALF + wc * 32 + 8 * fq;
        f32x4 wg0 = {1.f, 1.f, 1.f, 1.f}, wg1 = wg0, wu0 = wg0, wu1 = wg0;
        if constexpr (I8) { const float k = 1.0f / 127.0f; wg0 = *(const f32x4*)(cw + col0) * k; wg1 = *(const f32x4*)(cw + col0 + 4) * k; wu0 = *(const f32x4*)(cw + cup + col0) * k; wu1 = *(const f32x4*)(cw + cup + col0 + 4) * k; }
#pragma unroll
        for (int ai = 0; ai < 2; ++ai)
#pragma unroll
            for (int m = 0; m < 4; ++m) { const int row = row0 + ai * HALF + m * 16; const float sc = rs[row];
                f32x4 g0, g1, u0, u1;
                if constexpr (I8) { const v4i32 ig0 = __builtin_bit_cast(v4i32, acc[ai][0][m][0]), ig1 = __builtin_bit_cast(v4i32, acc[ai][0][m][1]), iu0 = __builtin_bit_cast(v4i32, acc[ai][1][m][0]), iu1 = __builtin_bit_cast(v4i32, acc[ai][1][m][1]);
                    g0 = __builtin_convertvector(ig0, f32x4) * wg0 * sc; g1 = __builtin_convertvector(ig1, f32x4) * wg1 * sc; u0 = __builtin_convertvector(iu0, f32x4) * wu0 * sc; u1 = __builtin_convertvector(iu1, f32x4) * wu1 * sc; }
                else { g0 = acc[ai][0][m][0] * sc; g1 = acc[ai][0][m][1] * sc; u0 = acc[ai][1][m][0] * sc; u1 = acc[ai][1][m][1] * sc; }
                if constexpr (F8) { typedef unsigned u32x2 __attribute__((ext_vector_type(2))); u32x2 w8;
                    w8.x = pk4_fp8(silu_mul(g0[0], u0[0]), silu_mul(g0[1], u0[1]), silu_mul(g0[2], u0[2]), silu_mul(g0[3], u0[3]));
                    w8.y = pk4_fp8(silu_mul(g1[0], u1[0]), silu_mul(g1[1], u1[1]), silu_mul(g1[2], u1[2]), silu_mul(g1[3], u1[3]));
                    *(u32x2*)((unsigned char*)O + (size_t)row * ldc + col0) = w8; continue; }
                bf16_t* rowp = O + (size_t)row * ldc + col0;
                u32x4 w;
                if constexpr (H16) { w.x = cvt_pk_f16(silu_mul(g0[0], u0[0]), silu_mul(g0[1], u0[1])); w.y = cvt_pk_f16(silu_mul(g0[2], u0[2]), silu_mul(g0[3], u0[3]));
                    w.z = cvt_pk_f16(silu_mul(g1[0], u1[0]), silu_mul(g1[1], u1[1])); w.w = cvt_pk_f16(silu_mul(g1[2], u1[2]), silu_mul(g1[3], u1[3])); }
                else { w.x = cvt_pk_bf16(silu_mul(g0[0], u0[0]), silu_mul(g0[1], u0[1])); w.y = cvt_pk_bf16(silu_mul(g0[2], u0[2]), silu_mul(g0[3], u0[3]));
                    w.z = cvt_pk_bf16(silu_mul(g1[0], u1[0]), silu_mul(g1[1], u1[1])); w.w = cvt_pk_bf16(silu_mul(g1[2], u1[2]), silu_mul(g1[3], u1[3])); }
#ifdef NT_H
                __builtin_nontemporal_store(w, (u32x4*)rowp); }
#else
                *(u32x4*)rowp = w; }
#endif
    }
};

template <class Epi, class Sched, bool ALIGN_EPI = false, bool SP2 = false, int MM = 0>
__device__ __forceinline__ void gemm_phase(PG8_LAS unsigned char* lds, const Gemm g, const Sched& S, const Epi& E) {
    const int tid = threadIdx.x, wid = __builtin_amdgcn_readfirstlane(tid >> 6), lane = tid & 63, wr = wid >> 2, wc = wid & 3, fr = lane & 15, fq = lane >> 4;
    const int K = g.K, nt = K / BK;
    unsigned voffA[2], voffB[2];
#pragma unroll
    for (int i = 0; i < 2; ++i) { int R, C; stage_rc(tid * 16 + i * 8192, R, C); const int Rb = Epi::PERM ? ((R & ~31) + perm32(R & 31)) : R;
        voffA[i] = (unsigned)(R * K + C) * 2u; voffB[i] = (unsigned)(Rb * K + C) * 2u; }
    const size_t kstep = (size_t)(BK * 2);
    const size_t hstep = (size_t)HALF * K * 2;
    const size_t tstep = 2 * hstep;
    const unsigned ldsw = (unsigned)wid * 1024u;
    const int aoff = lds_byte(wr * 64 + fr, fq * 8), boff = lds_byte(wc * 32 + fr, fq * 8);
#define PG8_SA(b, h) (((b) * 2 + (h)) * HTB)
#define PG8_SB(b, h) ((4 + (b) * 2 + (h)) * HTB)
#define PG8_STAGE(bufoff, gbase, voff) do { _Pragma("unroll") for (int _i = 0; _i < 2; ++_i) \
        __builtin_amdgcn_global_load_lds((const unsigned*)((const char*)(gbase) + (voff)[_i]), (PG8_LAS unsigned*)(lds + (bufoff) + ldsw + _i * 8192), 16, 0, 0); } while (0)
#define PG8_LDA(dst, b, h) do { _Pragma("unroll") for (int m = 0; m < 4; ++m) { if constexpr (MM == 1) dst##8[m] = cat8(*(const PG8_LAS bf16x8*)(lds + PG8_SA(b, h) + aoff + m * 2048), *(const PG8_LAS bf16x8*)(lds + PG8_SA(b, h) + aoff + m * 2048 + 1024)); \
        else { _Pragma("unroll") for (int k = 0; k < 2; ++k) dst[m][k] = *(const PG8_LAS bf16x8*)(lds + PG8_SA(b, h) + aoff + m * 2048 + k * 1024); } } } while (0)
#define PG8_LDB(dst, b, h) do { _Pragma("unroll") for (int n = 0; n < 2; ++n) { if constexpr (MM == 1) dst##8[n] = cat8(*(const PG8_LAS bf16x8*)(lds + PG8_SB(b, h) + boff + n * 2048), *(const PG8_LAS bf16x8*)(lds + PG8_SB(b, h) + boff + n * 2048 + 1024)); \
        else { _Pragma("unroll") for (int k = 0; k < 2; ++k) dst[n][k] = *(const PG8_LAS bf16x8*)(lds + PG8_SB(b, h) + boff + n * 2048 + k * 1024); } } } while (0)
#define PG8_MMA(ai, bj, At, Bt) do { __builtin_amdgcn_s_setprio(1); _Pragma("unroll") for (int m = 0; m < 4; ++m) _Pragma("unroll") for (int n = 0; n < 2; ++n) { \
        if constexpr (MM == 1) asm volatile("v_mfma_scale_f32_16x16x128_f8f6f4 %0, %1, %2, %0, %3, %3 op_sel_hi:[0,0,0]" : "+v"(acc[ai][bj][m][n]) : "v"(Bt##8[n]), "v"(At##8[m]), "v"(sc127));   \
        else if constexpr (MM == 2) { _Pragma("unroll") for (int k = 0; k < 2; ++k) acc[ai][bj][m][n] = __builtin_bit_cast(f32x4, __builtin_amdgcn_mfma_i32_16x16x64_i8(__builtin_bit_cast(v4i32, Bt[n][k]), __builtin_bit_cast(v4i32, At[m][k]), __builtin_bit_cast(v4i32, acc[ai][bj][m][n]), 0, 0, 0)); } \
        else { _Pragma("unroll") for (int k = 0; k < 2; ++k) acc[ai][bj][m][n] = __builtin_amdgcn_mfma_f32_16x16x32_bf16(Bt[n][k], At[m][k], acc[ai][bj][m][n], 0, 0, 0); } } \
        __builtin_amdgcn_s_setprio(0); } while (0)
#define PG8_WAIT_V(n) asm volatile("s_waitcnt vmcnt(" #n ")" ::: "memory")
#define PG8_WAIT_L(n) asm volatile("s_waitcnt lgkmcnt(" #n ")" ::: "memory")
#define PG8_BAR __builtin_amdgcn_s_barrier()
#define PG8_SCHED __builtin_amdgcn_sched_barrier(0)
    Unit cur, nxt; int ui = 0;
    if (!S.next(0, cur)) return;
    f32x4 acc[2][2][4][2];
#pragma unroll
    for (int a = 0; a < 2; ++a)
#pragma unroll
        for (int b = 0; b < 2; ++b)
#pragma unroll
            for (int m = 0; m < 4; ++m)
#pragma unroll
                for (int n = 0; n < 2; ++n) acc[a][b][m][n] = (f32x4){0.f, 0.f, 0.f, 0.f};
    bf16x8 At[4][2], B0[2][2], B1[2][2]; v8i32 At8[4], B08[2], B18[2]; const int sc127 = 0x7F7F7F7F;
    const char* cA = (const char*)g.A + (size_t)cur.pm * tstep; const char* cB = (const char*)g.Bt + (size_t)cur.pn * tstep;
    S.a_ready(cur);
    if constexpr (SP2) {
        PG8_STAGE(PG8_SB(0, 0), cB, voffB); PG8_STAGE(PG8_SB(0, 1), cB + hstep, voffB); PG8_STAGE(PG8_SA(0, 0), cA, voffA); PG8_STAGE(PG8_SA(0, 1), cA + hstep, voffA);
        if (wr == 1) PG8_BAR;
        PG8_WAIT_V(2); PG8_BAR;
        PG8_STAGE(PG8_SB(1, 0), cB + kstep, voffB); PG8_STAGE(PG8_SA(1, 0), cA + kstep, voffA); PG8_STAGE(PG8_SB(1, 1), cB + hstep + kstep, voffB);
        PG8_WAIT_V(6); PG8_BAR;
    } else {
        PG8_STAGE(PG8_SB(0, 0), cB, voffB); PG8_STAGE(PG8_SA(0, 0), cA, voffA); PG8_STAGE(PG8_SB(0, 1), cB + hstep, voffB); PG8_STAGE(PG8_SA(0, 1), cA + hstep, voffA);
        if (wr == 1) PG8_BAR;
        PG8_WAIT_V(4); PG8_BAR;
        PG8_STAGE(PG8_SB(1, 0), cB + kstep, voffB); PG8_STAGE(PG8_SA(1, 0), cA + kstep, voffA); PG8_STAGE(PG8_SB(1, 1), cB + hstep + kstep, voffB);
        PG8_WAIT_V(6); PG8_BAR;
    }
    for (;;) {
        const bool has_next = S.next(ui + 1, nxt);
        const char* nA = has_next ? (const char*)g.A + (size_t)nxt.pm * tstep : cA; const char* nB = has_next ? (const char*)g.Bt + (size_t)nxt.pn * tstep : cB;
        for (int t = 0; t < nt; t += 2) {
            const bool last = (t == nt - 2);
            const char* a1 = cA + (size_t)(t + 1) * kstep;
            const char* a2 = last ? nA : cA + (size_t)(t + 2) * kstep; const char* b2 = last ? nB : cB + (size_t)(t + 2) * kstep;
            const char* a3 = a2 + kstep; const char* b3 = b2 + kstep;
            if (last && has_next) S.a_ready(nxt);
            if constexpr (SP2) {
            PG8_LDB(B0, 0, 0); PG8_LDB(B1, 0, 1); PG8_SCHED; PG8_LDA(At, 0, 0); PG8_STAGE(PG8_SA(1, 1), a1 + hstep, voffA);
            PG8_WAIT_V(8); PG8_WAIT_L(0); PG8_BAR; PG8_MMA(0, 0, At, B0); PG8_MMA(0, 1, At, B1); PG8_BAR; PG8_SCHED;
            PG8_LDA(At, 0, 1); PG8_STAGE(PG8_SB(0, 0), b2, voffB); PG8_STAGE(PG8_SB(0, 1), b2 + hstep, voffB); PG8_STAGE(PG8_SA(0, 0), a2, voffA);
            PG8_WAIT_V(8); PG8_WAIT_L(0); PG8_BAR; PG8_MMA(1, 0, At, B0); PG8_MMA(1, 1, At, B1); PG8_BAR; PG8_SCHED;
            PG8_LDB(B0, 1, 0); PG8_LDB(B1, 1, 1); PG8_SCHED; PG8_LDA(At, 1, 0); PG8_STAGE(PG8_SA(0, 1), a2 + hstep, voffA);
            PG8_WAIT_V(8); PG8_WAIT_L(0); PG8_BAR; PG8_MMA(0, 0, At, B0); PG8_MMA(0, 1, At, B1); PG8_BAR; PG8_SCHED;
            PG8_LDA(At, 1, 1); PG8_STAGE(PG8_SB(1, 0), b3, voffB); PG8_STAGE(PG8_SB(1, 1), b3 + hstep, voffB); PG8_STAGE(PG8_SA(1, 0), a3, voffA);
            PG8_WAIT_V(8); PG8_WAIT_L(0); PG8_BAR; PG8_MMA(1, 0, At, B0); PG8_MMA(1, 1, At, B1); PG8_BAR; PG8_SCHED;
            } else {
            PG8_LDB(B0, 0, 0); PG8_SCHED; PG8_LDA(At, 0, 0); PG8_STAGE(PG8_SA(1, 1), a1 + hstep, voffA);
            PG8_WAIT_L(8); PG8_BAR; PG8_WAIT_L(0); PG8_MMA(0, 0, At, B0); PG8_BAR; PG8_SCHED;
            PG8_LDB(B1, 0, 1); PG8_STAGE(PG8_SB(0, 0), b2, voffB);
            PG8_BAR; PG8_WAIT_L(0); PG8_MMA(0, 1, At, B1); PG8_BAR;
            PG8_LDA(At, 0, 1); PG8_STAGE(PG8_SA(0, 0), a2, voffA);
            PG8_BAR; PG8_WAIT_L(0); PG8_MMA(1, 0, At, B0); PG8_BAR; PG8_SCHED;
            PG8_STAGE(PG8_SB(0, 1), b2 + hstep, voffB);
            PG8_WAIT_V(6); PG8_BAR; PG8_MMA(1, 1, At, B1); PG8_BAR;
            PG8_LDB(B0, 1, 0); PG8_SCHED; PG8_LDA(At, 1, 0); PG8_STAGE(PG8_SA(0, 1), a2 + hstep, voffA);
            PG8_WAIT_L(8); PG8_BAR; PG8_WAIT_L(0); PG8_MMA(0, 0, At, B0); PG8_BAR; PG8_SCHED;
            PG8_LDB(B1, 1, 1); PG8_STAGE(PG8_SB(1, 0), b3, voffB);
            PG8_BAR; PG8_WAIT_L(0); PG8_MMA(0, 1, At, B1); PG8_BAR;
            PG8_LDA(At, 1, 1); PG8_STAGE(PG8_SA(1, 0), a3, voffA);
            PG8_BAR; PG8_WAIT_L(0); PG8_MMA(1, 0, At, B0); PG8_BAR; PG8_SCHED;
            PG8_STAGE(PG8_SB(1, 1), b3 + hstep, voffB);
            PG8_WAIT_V(6); PG8_BAR; PG8_MMA(1, 1, At, B1); PG8_BAR;
            }
        }
        if constexpr (MM == 1) asm volatile("s_nop 15\n\ts_nop 15" ::: "memory");
        if constexpr (ALIGN_EPI) { if (wr == 0) PG8_BAR; }
        if constexpr (!Epi::AFTER_DRAIN) { E(acc, cur, wr, wc, fr, fq); S.done(cur); }
        if (!has_next) break;
#pragma unroll
        for (int a = 0; a < 2; ++a)
#pragma unroll
            for (int b = 0; b < 2; ++b)
#pragma unroll
                for (int m = 0; m < 4; ++m)
#pragma unroll
                    for (int n = 0; n < 2; ++n) acc[a][b][m][n] = (f32x4){0.f, 0.f, 0.f, 0.f};
        cur = nxt; cA = nA; cB = nB; ++ui;
        if constexpr (ALIGN_EPI) { if (wr == 1) PG8_BAR; }
    }
    PG8_WAIT_V(0);
    if constexpr (!ALIGN_EPI) { if (wr == 0) PG8_BAR; }
    PG8_BAR;
    if constexpr (Epi::AFTER_DRAIN) { E.fused(acc, cur, wr, wc, fr, fq, lds, wid, lane); S.done(cur); }
#undef PG8_SA
#undef PG8_SB
#undef PG8_STAGE
#undef PG8_LDA
#undef PG8_LDB
#undef PG8_MMA
#undef PG8_WAIT_V
#undef PG8_WAIT_L
#undef PG8_BAR
#undef PG8_SCHED
}
}
namespace attn {
using bf16 = unsigned short;
constexpr int   D = 128, NW = 8, QBLK = 32, KVBLK = 64;
constexpr float SCALE = 0.088388347648318440f;
constexpr float THR = 8.f;
#ifndef ATTN_QPRE
#define ATTN_QPRE 1
#endif
constexpr bool QPRE = ATTN_QPRE != 0;
constexpr float QC = SCALE * 1.4426950408889634f;
constexpr int SDEPTH = 2;
#ifndef KSWZ_MASK
#define KSWZ_MASK 15
#endif
constexpr int LDQ = 9216, LDK = 128, LDO = 2048;
constexpr size_t SHM_V = KVBLK * D * 2, SHM_K = KVBLK * D * 2, SHM_ATTN = 2 * SHM_V + 2 * SHM_K + NW * 64 * 4;
#define LD8(p) (*reinterpret_cast<const bf16x8*>(p))
using bf16x8 = __attribute__((ext_vector_type(8))) short;
using s16x4  = __attribute__((ext_vector_type(4))) short;
using f32x16 = __attribute__((ext_vector_type(16))) float;
using f32x8  = __attribute__((ext_vector_type(8))) float;
using u32x4  = __attribute__((ext_vector_type(4))) unsigned;
#define KSWZ(row, colB) ((row) * 256 + ((colB) ^ (((row) & KSWZ_MASK) << 4)))
#define SBAR() __builtin_amdgcn_sched_barrier(0)
__device__ __forceinline__ int crow(int r, int hi) { return (r & 3) + 8 * (r >> 2) + 4 * hi; }
__device__ __forceinline__ unsigned cvtpk(float lo, float hi) {
  unsigned r; asm volatile("v_cvt_pk_bf16_f32 %0, %1, %2" : "=v"(r) : "v"(lo), "v"(hi)); return r;
}
__device__ __forceinline__ void partialSM(f32x16& p0, f32x16& p1, float& m_reg, float& mn, float& alpha) {
  constexpr float C = QPRE ? 1.0f : QC;
  float pmax = p0[0]; for (int r = 1; r < 16; ++r) pmax = fmaxf(pmax, p0[r]); for (int r = 0; r < 16; ++r) pmax = fmaxf(pmax, p1[r]);
  { auto rr = __builtin_amdgcn_permlane32_swap(__float_as_uint(pmax), __float_as_uint(pmax), false, false);
    pmax = fmaxf(__uint_as_float(rr[0]), __uint_as_float(rr[1])); }
  if (__builtin_expect(__all(pmax - m_reg <= (QPRE ? THR * 1.4426950408889634f : THR / SCALE)), 1)) { mn = m_reg; alpha = 1.f; }
  else { mn = fmaxf(m_reg, pmax); alpha = __builtin_amdgcn_exp2f((m_reg - mn) * C); m_reg = mn; }
  float mnC = -mn * C;
  for (int r = 0; r < 16; ++r) p0[r] = fmaf(p0[r], C, mnC); for (int r = 0; r < 16; ++r) p1[r] = fmaf(p1[r], C, mnC);
  for (int r = 0; r < 16; ++r) p0[r] = __builtin_amdgcn_exp2f(p0[r]);
}
__device__ __forceinline__ void finishSM(f32x16& p0, f32x16& p1, float alpha, float& l_reg, bf16x8& pa0, bf16x8& pa1, bf16x8& pa2, bf16x8& pa3) {
  for (int r = 0; r < 16; ++r) p1[r] = __builtin_amdgcn_exp2f(p1[r]);
  float ps = 0; for (int r = 0; r < 16; ++r) ps += p0[r]; for (int r = 0; r < 16; ++r) ps += p1[r];
  { auto rr = __builtin_amdgcn_permlane32_swap(__float_as_uint(ps), __float_as_uint(ps), false, false);
    ps = __uint_as_float(rr[0]) + __uint_as_float(rr[1]); }
  l_reg = l_reg * alpha + ps;
#define PK4(P, BASE, OUT) do { unsigned a0 = cvtpk(P[BASE + 0], P[BASE + 1]), a1 = cvtpk(P[BASE + 2], P[BASE + 3]);   \
    unsigned b0 = cvtpk(P[BASE + 4], P[BASE + 5]), b1 = cvtpk(P[BASE + 6], P[BASE + 7]);                              \
    auto r0 = __builtin_amdgcn_permlane32_swap(a0, b0, false, false); auto r1 = __builtin_amdgcn_permlane32_swap(a1, b1, false, false); \
    u32x4 w = {r0[0], r1[0], r0[1], r1[1]}; OUT = *reinterpret_cast<bf16x8*>(&w); } while (0)
  PK4(p0, 0, pa0); PK4(p0, 8, pa1); PK4(p1, 0, pa2); PK4(p1, 8, pa3);
#undef PK4
}
__device__ __forceinline__ void fastSM(f32x16& p0, f32x16& p1, float& l_part, bf16x8& pa0, bf16x8& pa1, bf16x8& pa2, bf16x8& pa3) {
  for (int r = 0; r < 16; ++r) p0[r] = __builtin_amdgcn_exp2f(p0[r]);
  for (int r = 0; r < 16; ++r) p1[r] = __builtin_amdgcn_exp2f(p1[r]);
  float ps = 0; for (int r = 0; r < 16; ++r) ps += p0[r]; for (int r = 0; r < 16; ++r) ps += p1[r];
  l_part += ps;
#define PK4(P, BASE, OUT) do { unsigned a0 = cvtpk(P[BASE + 0], P[BASE + 1]), a1 = cvtpk(P[BASE + 2], P[BASE + 3]);   \
    unsigned b0 = cvtpk(P[BASE + 4], P[BASE + 5]), b1 = cvtpk(P[BASE + 6], P[BASE + 7]);                              \
    auto r0 = __builtin_amdgcn_permlane32_swap(a0, b0, false, false); auto r1 = __builtin_amdgcn_permlane32_swap(a1, b1, false, false); \
    u32x4 w = {r0[0], r1[0], r0[1], r1[1]}; OUT = *reinterpret_cast<bf16x8*>(&w); } while (0)
  PK4(p0, 0, pa0); PK4(p0, 8, pa1); PK4(p1, 0, pa2); PK4(p1, 8, pa3);
#undef PK4
}
__device__ __forceinline__ void qkt(f32x16& p0, f32x16& p1, const bf16* Ks, const bf16x8* qr, int r32, int hi) {
  p0 = f32x16{}; p1 = f32x16{};
#ifdef ATTN_PRIO
  __builtin_amdgcn_s_setprio(1);
#endif
  for (int d0 = 0; d0 < 8; ++d0) { int cb = (d0 * 16 + hi * 8) * 2;
    bf16x8 b0 = *reinterpret_cast<const bf16x8*>((const char*)Ks + KSWZ(r32, cb));
    bf16x8 b1 = *reinterpret_cast<const bf16x8*>((const char*)Ks + KSWZ(32 + r32, cb));
    p0 = __builtin_amdgcn_mfma_f32_32x32x16_bf16(b0, qr[d0], p0, 0, 0, 0);
    p1 = __builtin_amdgcn_mfma_f32_32x32x16_bf16(b1, qr[d0], p1, 0, 0, 0); }
#ifdef ATTN_PRIO
  __builtin_amdgcn_s_setprio(0);
#endif
}
__device__ __forceinline__ int v_st(int k, int c) { const int kk = (k & ~0xC) | ((k & 4) << 1) | ((k & 8) >> 1); return ((kk >> 3) * 4 + (c >> 5)) * 512 + ((kk & 7) * 32 + (c & 31)) * 2; }
__device__ __forceinline__ int v_rd_base(int lane) { return ((lane & 3) << 3) | (((lane >> 2) & 3) << 6) | (((lane >> 4) & 1) << 5) | (((lane >> 5) & 1) << 8); }
constexpr int v_rd_off(int d0, int ks, int half) { return d0 * 512 + ks * 4096 + half * 2048; }
template <int OFF> __device__ __forceinline__ s16x4 tr_read(int vb) {
  s16x4 r; asm volatile("ds_read_b64_tr_b16 %0, %1 offset:%2" : "=&v"(r) : "v"(vb), "i"(OFF) : "memory"); return r;
}
template <int D0> __device__ __forceinline__ void pv_one(f32x16& od, int vb, bf16x8 pa0, bf16x8 pa1, bf16x8 pa2, bf16x8 pa3) {
  const s16x4 l0 = tr_read<v_rd_off(D0, 0, 0)>(vb), h0 = tr_read<v_rd_off(D0, 0, 1)>(vb), l1 = tr_read<v_rd_off(D0, 1, 0)>(vb), h1 = tr_read<v_rd_off(D0, 1, 1)>(vb);
  const s16x4 l2 = tr_read<v_rd_off(D0, 2, 0)>(vb), h2 = tr_read<v_rd_off(D0, 2, 1)>(vb), l3 = tr_read<v_rd_off(D0, 3, 0)>(vb), h3 = tr_read<v_rd_off(D0, 3, 1)>(vb);
  asm volatile("s_waitcnt lgkmcnt(0)" ::: "memory"); SBAR();
#define PK(L, H) (bf16x8){L[0], L[1], L[2], L[3], H[0], H[1], H[2], H[3]}
  od = __builtin_amdgcn_mfma_f32_32x32x16_bf16(pa0, PK(l0, h0), od, 0, 0, 0);
  od = __builtin_amdgcn_mfma_f32_32x32x16_bf16(pa1, PK(l1, h1), od, 0, 0, 0);
  od = __builtin_amdgcn_mfma_f32_32x32x16_bf16(pa2, PK(l2, h2), od, 0, 0, 0);
  od = __builtin_amdgcn_mfma_f32_32x32x16_bf16(pa3, PK(l3, h3), od, 0, 0, 0);
#undef PK
}
__device__ __forceinline__ void pv_d0(f32x16* o, int vb, bf16x8 pa0, bf16x8 pa1, bf16x8 pa2, bf16x8 pa3) {
#ifdef ATTN_PRIO
  __builtin_amdgcn_s_setprio(1);
#endif
  pv_one<0>(o[0], vb, pa0, pa1, pa2, pa3); pv_one<1>(o[1], vb, pa0, pa1, pa2, pa3); pv_one<2>(o[2], vb, pa0, pa1, pa2, pa3); pv_one<3>(o[3], vb, pa0, pa1, pa2, pa3);
#ifdef ATTN_PRIO
  __builtin_amdgcn_s_setprio(0);
#endif
}

__device__ __forceinline__ void attn_dense_body(const bf16* __restrict__ Qb, const bf16* __restrict__ Kh, const bf16* __restrict__ Vh,
                                                bf16* __restrict__ Ob, int seq, char* lds) {
  const int tid = threadIdx.x, wid = tid >> 6, lane = tid & 63, r32 = lane & 31, hi = lane >> 5;
  bf16* V_lds = (bf16*)lds; bf16* K_lds = (bf16*)(lds + 2 * SHM_V);
  float* ws = (float*)(lds + 2 * SHM_V + 2 * SHM_K) + wid * 64; float* li_l = ws; float* al_l = ws + 32;
  float m_reg = -1e30f, l_reg = 0; f32x16 o[4] = {}; bf16x8 qr[8];
  const bf16* Qw = Qb + (long)(wid * QBLK + r32) * LDQ + hi * 8;
#pragma unroll
  for (int d0 = 0; d0 < 8; ++d0) qr[d0] = *reinterpret_cast<const bf16x8*>(Qw + d0 * 16);
  const int sr = tid >> 4, sc = (tid & 15) * 8, vst0 = v_st(sr, sc), vst1 = v_st(32 + sr, sc);
  const int vb0 = (int)(uintptr_t)V_lds + v_rd_base(lane);
  struct { bf16x8 vs0, vs1, ks0, ks1; } sr_[SDEPTH];
#define SLOAD(i, k0) do { sr_[i].vs0 = LD8(&Vh[(long)((k0) + sr) * LDK + sc]); sr_[i].vs1 = LD8(&Vh[(long)((k0) + 32 + sr) * LDK + sc]); \
    sr_[i].ks0 = LD8(&Kh[(long)((k0) + sr) * LDK + sc]); sr_[i].ks1 = LD8(&Kh[(long)((k0) + 32 + sr) * LDK + sc]); } while (0)
#define SWRITE(b, i) do { *(bf16x8*)((char*)V_lds + (b) * SHM_V + vst0) = (sr_[i].vs0);          \
    *(bf16x8*)((char*)V_lds + (b) * SHM_V + vst1) = (sr_[i].vs1); int kc = sc * 2;               \
    *(bf16x8*)((char*)K_lds + (b) * SHM_K + KSWZ(sr, kc)) = (sr_[i].ks0);                       \
    *(bf16x8*)((char*)K_lds + (b) * SHM_K + KSWZ(32 + sr, kc)) = (sr_[i].ks1); } while (0)
#define SWAIT() do { if constexpr (SDEPTH == 2) asm volatile("s_waitcnt vmcnt(4)" ::: "memory"); else asm volatile("s_waitcnt vmcnt(0)" ::: "memory"); } while (0)
#define RESC(a) do { if (__any((a) < 1.f)) { if (hi == 0) al_l[r32] = (a); asm volatile("s_waitcnt lgkmcnt(0)" ::: "memory"); \
    for (int d = 0; d < 4; ++d) for (int r = 0; r < 16; ++r) o[d][r] *= al_l[crow(r, hi)]; } } while (0)
  f32x16 pA0, pA1, pB0, pB1; float mnA, mnB, alA, alB; bf16x8 pa0, pa1, pa2, pa3; const int NT = seq / KVBLK;
  constexpr int SE = 0, SO = SDEPTH - 1;
  SLOAD(SE, 0); asm volatile("s_waitcnt vmcnt(0)" ::: "memory"); SWRITE(0, SE); __syncthreads();
  qkt(pA0, pA1, K_lds, qr, r32, hi); partialSM(pA0, pA1, m_reg, mnA, alA);
  SLOAD(SO, KVBLK); if constexpr (SDEPTH == 2) { if (2 < NT) SLOAD(SE, 2 * KVBLK); }
  SWAIT(); SWRITE(1, SO); __syncthreads();
  for (int j = 1; j + 1 < NT; j += 2) {
    SBAR(); qkt(pB0, pB1, (bf16*)((char*)K_lds + SHM_K), qr, r32, hi);
    finishSM(pA0, pA1, alA, l_reg, pa0, pa1, pa2, pa3); SBAR();
    SLOAD(SO, (j + SDEPTH) * KVBLK); SBAR();
    pv_d0(o, vb0, pa0, pa1, pa2, pa3); partialSM(pB0, pB1, m_reg, mnB, alB);
    __syncthreads(); SWAIT(); SWRITE(0, SE);
    RESC(alB); __syncthreads();
    SBAR(); qkt(pA0, pA1, K_lds, qr, r32, hi);
    finishSM(pB0, pB1, alB, l_reg, pa0, pa1, pa2, pa3); SBAR();
    if (SDEPTH == 1 || j + 3 < NT) SLOAD(SE, (j + 1 + SDEPTH) * KVBLK); SBAR();
    pv_d0(o, vb0 + (int)SHM_V, pa0, pa1, pa2, pa3); partialSM(pA0, pA1, m_reg, mnA, alA);
    __syncthreads(); SWAIT(); SWRITE(1, SO);
    RESC(alA); __syncthreads();
  }
  SBAR(); qkt(pB0, pB1, (bf16*)((char*)K_lds + SHM_K), qr, r32, hi);
  finishSM(pA0, pA1, alA, l_reg, pa0, pa1, pa2, pa3); SBAR();
  pv_d0(o, vb0, pa0, pa1, pa2, pa3); partialSM(pB0, pB1, m_reg, mnB, alB);
  __syncthreads(); RESC(alB);
  finishSM(pB0, pB1, alB, l_reg, pa0, pa1, pa2, pa3); SBAR();
  pv_d0(o, vb0 + (int)SHM_V, pa0, pa1, pa2, pa3);
  if (hi == 0) li_l[r32] = l_reg; asm volatile("s_waitcnt lgkmcnt(0)" ::: "memory");
  float rli[16];
#pragma unroll
  for (int r = 0; r < 16; ++r) rli[r] = __builtin_amdgcn_rcpf(li_l[crow(r, hi)]);
  bf16* Ow = Ob + (long)(wid * QBLK) * LDO;
#pragma unroll
  for (int r = 0; r < 16; ++r) { int orow = crow(r, hi);
    for (int d0 = 0; d0 < 4; ++d0) Ow[(long)orow * LDO + d0 * 32 + r32] = (bf16)(cvtpk(o[d0][r] * rli[r], 0.f) & 0xffffu); }
#undef SLOAD
#undef SWRITE
#undef SWAIT
#undef RESC
}


#define DSR128(dst, addr, off) asm volatile("ds_read_b128 %0, %1 offset:%2" : "=&v"(dst) : "v"(addr), "i"(off) : "memory")
#define LGKM(n) do { SBAR(); asm volatile("s_waitcnt lgkmcnt(" #n ")" ::: "memory"); SBAR(); } while (0)
struct VChunk { s16x4 l0, h0, l1, h1, l2, h2, l3, h3; };
struct KChunk { bf16x8 a0, a1, b0, b1; };
template <int D0> __device__ __forceinline__ void v_issue(VChunk& c, int vb) {
  c.l0 = tr_read<v_rd_off(D0, 0, 0)>(vb); c.h0 = tr_read<v_rd_off(D0, 0, 1)>(vb); c.l1 = tr_read<v_rd_off(D0, 1, 0)>(vb); c.h1 = tr_read<v_rd_off(D0, 1, 1)>(vb);
  c.l2 = tr_read<v_rd_off(D0, 2, 0)>(vb); c.h2 = tr_read<v_rd_off(D0, 2, 1)>(vb); c.l3 = tr_read<v_rd_off(D0, 3, 0)>(vb); c.h3 = tr_read<v_rd_off(D0, 3, 1)>(vb);
}
__device__ __forceinline__ void v_mma(f32x16& od, const VChunk& c, bf16x8 pa0, bf16x8 pa1, bf16x8 pa2, bf16x8 pa3) {
#define PK(L, H) (bf16x8){L[0], L[1], L[2], L[3], H[0], H[1], H[2], H[3]}
  od = __builtin_amdgcn_mfma_f32_32x32x16_bf16(pa0, PK(c.l0, c.h0), od, 0, 0, 0); od = __builtin_amdgcn_mfma_f32_32x32x16_bf16(pa1, PK(c.l1, c.h1), od, 0, 0, 0);
  od = __builtin_amdgcn_mfma_f32_32x32x16_bf16(pa2, PK(c.l2, c.h2), od, 0, 0, 0); od = __builtin_amdgcn_mfma_f32_32x32x16_bf16(pa3, PK(c.l3, c.h3), od, 0, 0, 0);
#undef PK
}
template <int C> __device__ __forceinline__ void k_issue(KChunk& c, int krow, int sxh) {
  const int ad0 = krow + (((2 * C) * 32) ^ sxh), ad1 = krow + (((2 * C + 1) * 32) ^ sxh);
  DSR128(c.a0, ad0, 0); DSR128(c.a1, ad0, 32 * 256); DSR128(c.b0, ad1, 0); DSR128(c.b1, ad1, 32 * 256);
}
template <int C> __device__ __forceinline__ void k_mma(f32x16& p0, f32x16& p1, const KChunk& c, const bf16x8* qr) {
  if (C == 0) { p0 = __builtin_amdgcn_mfma_f32_32x32x16_bf16(c.a0, qr[0], f32x16{}, 0, 0, 0); p1 = __builtin_amdgcn_mfma_f32_32x32x16_bf16(c.a1, qr[0], f32x16{}, 0, 0, 0); }
  else { p0 = __builtin_amdgcn_mfma_f32_32x32x16_bf16(c.a0, qr[2 * C], p0, 0, 0, 0); p1 = __builtin_amdgcn_mfma_f32_32x32x16_bf16(c.a1, qr[2 * C], p1, 0, 0, 0); }
  p0 = __builtin_amdgcn_mfma_f32_32x32x16_bf16(c.b0, qr[2 * C + 1], p0, 0, 0, 0); p1 = __builtin_amdgcn_mfma_f32_32x32x16_bf16(c.b1, qr[2 * C + 1], p1, 0, 0, 0);
}
#ifndef PP_EARLY_LOADS
#define PP_EARLY_LOADS 1
#endif
#ifndef PP_PRIO_X
#define PP_PRIO_X 1
#endif
#ifndef PP_PRIO_Y
#define PP_PRIO_Y 0
#endif
constexpr size_t SHM_PP = 3 * SHM_K + 3 * SHM_V + NW * 64 * 4;
#define PP_BAR() asm volatile("s_waitcnt lgkmcnt(0)\n\ts_barrier" ::: "memory")
#ifdef PROBE_PP_T
#define PP_T(k) do { const unsigned long long t_ = __builtin_amdgcn_s_memtime(); tacc[k] += t_ - tlast; tlast = t_; } while (0)
#else
#define PP_T(k) do { } while (0)
#endif
template <bool FAST  >
__device__ __forceinline__ void attn_pp_body(const bf16* __restrict__ Qb, const bf16* __restrict__ Kh, const bf16* __restrict__ Vh, bf16* __restrict__ Ob, int seq, char* lds, unsigned long long* tacc_out = nullptr) {
#ifdef PROBE_PP_T
  unsigned long long tacc[4] = {0ull, 0ull, 0ull, 0ull}, tlast = 0ull;
#endif
  int tid_ = threadIdx.x; asm volatile("" : "+v"(tid_));
  const int tid = tid_, wid = __builtin_amdgcn_readfirstlane(tid >> 6), lane = tid & 63, r32 = lane & 31, hi = lane >> 5;
  const bool trailing = wid >= 4;
  char* const K_lds = lds; char* const V_lds = lds + 3 * SHM_K;
  float* ws = (float*)(lds + 3 * SHM_K + 3 * SHM_V) + wid * 64; float* li_l = ws; float* al_l = ws + 32;
  float m_reg = -1e30f, l_reg = 0; f32x16 o[4] = {}; bf16x8 qr[8];
  const bf16* Qw = Qb + (long)(wid * QBLK + r32) * LDQ + hi * 8;
#pragma unroll
  for (int d0 = 0; d0 < 8; ++d0) qr[d0] = *reinterpret_cast<const bf16x8*>(Qw + d0 * 16);
  const int sr = tid >> 4, sc = (tid & 15) * 8, vst0 = v_st(sr, sc), vst1 = v_st(32 + sr, sc), kst0 = KSWZ(sr, sc * 2), kst1 = KSWZ(32 + sr, sc * 2);
  const int vb0 = (int)(uintptr_t)V_lds + v_rd_base(lane), sx6 = ((r32 & KSWZ_MASK) << 4) & 0xE0, krow = (int)(uintptr_t)K_lds + r32 * 256 + ((hi * 16) ^ (((r32 & KSWZ_MASK) << 4) & 0x10));
  const int NT = seq / KVBLK;
  const bf16* const Kt = Kh + (long)sr * LDK + sc; const bf16* const Vt = Vh + (long)sr * LDK + sc;
#define PP_TILE(base, t) ((base) + (long)(t) * (KVBLK * LDK))
#define RESC(a) do { if (__any((a) < 1.f)) { if (hi == 0) al_l[r32] = (a); asm volatile("s_waitcnt lgkmcnt(0)" ::: "memory"); \
    for (int d = 0; d < 4; ++d) for (int r = 0; r < 16; ++r) o[d][r] *= al_l[crow(r, hi)]; } } while (0)
  {
    const bf16x8 a0 = LD8(PP_TILE(Kt, 0)), a1 = LD8(PP_TILE(Kt, 0) + 32 * LDK), b0 = LD8(PP_TILE(Kt, 1)), b1 = LD8(PP_TILE(Kt, 1) + 32 * LDK), c0 = LD8(PP_TILE(Kt, 2)), c1 = LD8(PP_TILE(Kt, 2) + 32 * LDK);
    const bf16x8 d0 = LD8(PP_TILE(Vt, 0)), d1 = LD8(PP_TILE(Vt, 0) + 32 * LDK), e0 = LD8(PP_TILE(Vt, 1)), e1 = LD8(PP_TILE(Vt, 1) + 32 * LDK);
    *(bf16x8*)(K_lds + 0 * SHM_K + kst0) = a0; *(bf16x8*)(K_lds + 0 * SHM_K + kst1) = a1; *(bf16x8*)(K_lds + 1 * SHM_K + kst0) = b0; *(bf16x8*)(K_lds + 1 * SHM_K + kst1) = b1;
    *(bf16x8*)(K_lds + 2 * SHM_K + kst0) = c0; *(bf16x8*)(K_lds + 2 * SHM_K + kst1) = c1;
    *(bf16x8*)(V_lds + 0 * SHM_V + vst0) = d0; *(bf16x8*)(V_lds + 0 * SHM_V + vst1) = d1; *(bf16x8*)(V_lds + 1 * SHM_V + vst0) = e0; *(bf16x8*)(V_lds + 1 * SHM_V + vst1) = e1;
  }
  PP_BAR();
  f32x16 s0, s1; float mn, al; bf16x8 pa0, pa1, pa2, pa3;
  qkt(s0, s1, (const bf16*)K_lds, qr, r32, hi);
  if constexpr (FAST) fastSM(s0, s1, l_reg, pa0, pa1, pa2, pa3);
  else { partialSM(s0, s1, m_reg, mn, al); finishSM(s0, s1, al, l_reg, pa0, pa1, pa2, pa3); }
  if (trailing) PP_BAR();
  int kr = 1, vr = 0, kw = 0, vw = 2;
#ifdef PROBE_PP_T
  tlast = __builtin_amdgcn_s_memtime();
#endif
  for (int i = 0; i < NT; ++i) {
#if PP_EARLY_LOADS
    const int tk = (i + 3 < NT) ? i + 3 : NT - 1, tv = (i + 2 < NT) ? i + 2 : NT - 1;
    const bf16x8 gk0 = LD8(PP_TILE(Kt, tk)), gk1 = LD8(PP_TILE(Kt, tk) + 32 * LDK), gv0 = LD8(PP_TILE(Vt, tv)), gv1 = LD8(PP_TILE(Vt, tv) + 32 * LDK);
#endif
    SBAR(); __builtin_amdgcn_s_setprio(PP_PRIO_X);
    { const int vb = vb0 + vr * (int)SHM_V, kro = krow + kr * (int)SHM_K; VChunk v0, v1, v2, v3;
      v_issue<0>(v0, vb); v_issue<1>(v1, vb);
      LGKM(8); v_mma(o[0], v0, pa0, pa1, pa2, pa3); v_issue<2>(v2, vb);
      LGKM(8); v_mma(o[1], v1, pa0, pa1, pa2, pa3); v_issue<3>(v3, vb);
      if (i + 1 < NT) { KChunk k0, k1, k2, k3;
        LGKM(8); v_mma(o[2], v2, pa0, pa1, pa2, pa3); k_issue<0>(k0, kro, sx6);
        LGKM(4); v_mma(o[3], v3, pa0, pa1, pa2, pa3); k_issue<1>(k1, kro, sx6);
        LGKM(4); k_mma<0>(s0, s1, k0, qr); k_issue<2>(k2, kro, sx6);
        LGKM(4); k_mma<1>(s0, s1, k1, qr); k_issue<3>(k3, kro, sx6);
        LGKM(4); k_mma<2>(s0, s1, k2, qr);
        LGKM(0); k_mma<3>(s0, s1, k3, qr);
      } else { LGKM(8); v_mma(o[2], v2, pa0, pa1, pa2, pa3); LGKM(0); v_mma(o[3], v3, pa0, pa1, pa2, pa3); }
    }
#ifdef PROBE_PP_X
    { f32x16 dm = {}; for (int q = 0; q < PROBE_PP_X; ++q) dm = __builtin_amdgcn_mfma_f32_32x32x16_bf16(qr[q & 7], qr[(q + 1) & 7], dm, 0, 0, 0); asm volatile("" :: "v"(dm)); }
#endif
    __builtin_amdgcn_s_setprio(PP_PRIO_Y);
    PP_T(0);
    PP_BAR();
    PP_T(1);
#ifdef PROBE_PP_Y
    { float dt = (float)i; for (int q = 0; q < PROBE_PP_Y; ++q) dt = fmaf(dt, 1.0001f, 0.5f); asm volatile("" :: "v"(dt)); }
#endif
#if !PP_EARLY_LOADS
    const int tk = (i + 3 < NT) ? i + 3 : NT - 1, tv = (i + 2 < NT) ? i + 2 : NT - 1;
    const bf16x8 gk0 = LD8(PP_TILE(Kt, tk)), gk1 = LD8(PP_TILE(Kt, tk) + 32 * LDK), gv0 = LD8(PP_TILE(Vt, tv)), gv1 = LD8(PP_TILE(Vt, tv) + 32 * LDK);
    SBAR();
#endif
    if constexpr (FAST) {
      *(bf16x8*)(K_lds + kw * SHM_K + kst0) = gk0; *(bf16x8*)(K_lds + kw * SHM_K + kst1) = gk1; *(bf16x8*)(V_lds + vw * SHM_V + vst0) = gv0; *(bf16x8*)(V_lds + vw * SHM_V + vst1) = gv1;
      if (i + 1 < NT) fastSM(s0, s1, l_reg, pa0, pa1, pa2, pa3);
    } else {
      if (i + 1 < NT) { partialSM(s0, s1, m_reg, mn, al); finishSM(s0, s1, al, l_reg, pa0, pa1, pa2, pa3); RESC(al); }
      *(bf16x8*)(K_lds + kw * SHM_K + kst0) = gk0; *(bf16x8*)(K_lds + kw * SHM_K + kst1) = gk1; *(bf16x8*)(V_lds + vw * SHM_V + vst0) = gv0; *(bf16x8*)(V_lds + vw * SHM_V + vst1) = gv1;
    }
    PP_T(2);
    PP_BAR();
    PP_T(3);
    kr = (kr == 2) ? 0 : kr + 1; vr = (vr == 2) ? 0 : vr + 1; kw = (kw == 2) ? 0 : kw + 1; vw = (vw == 2) ? 0 : vw + 1;
  }
#ifdef PROBE_PP_T
  if (tacc_out && tid == 0 && blockIdx.x == 0) { tacc_out[0] += tacc[0]; tacc_out[1] += tacc[1]; tacc_out[2] += tacc[2]; tacc_out[3] += tacc[3]; }
#endif
  __builtin_amdgcn_s_setprio(0);
  if (!trailing) PP_BAR();
  if constexpr (FAST) { auto rr = __builtin_amdgcn_permlane32_swap(__float_as_uint(l_reg), __float_as_uint(l_reg), false, false); l_reg = __uint_as_float(rr[0]) + __uint_as_float(rr[1]); }
  if (hi == 0) li_l[r32] = l_reg; asm volatile("s_waitcnt lgkmcnt(0)" ::: "memory");
  float rli[16];
#pragma unroll
  for (int r = 0; r < 16; ++r) rli[r] = __builtin_amdgcn_rcpf(li_l[crow(r, hi)]);
  bf16* Ow = Ob + (long)(wid * QBLK) * LDO;
#pragma unroll
  for (int r = 0; r < 16; ++r) { int orow = crow(r, hi);
    for (int d0 = 0; d0 < 4; ++d0) Ow[(long)orow * LDO + d0 * 32 + r32] = (bf16)(cvtpk(o[d0][r] * rli[r], 0.f) & 0xffffu); }
#undef RESC
#undef PP_TILE
}

#undef LD8
#undef KSWZ
}

constexpr int NWAVES = 8;
#ifndef MK_PER_PHASE
#define MK_PER_PHASE 0
#endif
constexpr int N_PHASES = 15;

constexpr int DM = 4096, FF = 11008, NPROJ = 9216, AW = 2048, KVW = 512, CW = 2048, HD = 128;
constexpr int M_PROMPT = 4 * 4096, M_SAMPLE = 16384, M = M_PROMPT + M_SAMPLE;
constexpr int S_PROMPT = 4096, S_SAMPLE = 16384;
constexpr int PO_Q = 0, PO_K = 2048, PO_V = 2560, PO_B = 3072, PO_C = 5120, PO_H = 7168;
constexpr float EPS = 1e-6f;

constexpr size_t MiB = 1u << 20;
constexpr size_t WS_CTL = 0, CTL_ZERO_BYTES = 288 * 1024;
constexpr size_t WS_ROPE = 1 * MiB;
constexpr size_t WS_RINV = 1 * MiB + 256 * 1024;
constexpr size_t WS_WA = 2 * MiB;
constexpr size_t WS_WD = 174 * MiB;
constexpr size_t WS_WIN = 260 * MiB;
constexpr size_t WS_WOUT = 332 * MiB;
constexpr size_t WS_XN = 364 * MiB;
constexpr size_t WS_Y = 620 * MiB;
constexpr size_t WS_H = 876 * MiB;
constexpr size_t WS_KC = 1564 * MiB, WS_VC = 1596 * MiB;
constexpr size_t WS_END = 1628 * MiB;
static_assert(WS_WA + (size_t)2 * FF * DM * 2 <= WS_WD && WS_WD + (size_t)DM * FF * 2 <= WS_WIN && WS_WIN + (size_t)NPROJ * DM * 2 <= WS_WOUT && WS_WOUT + (size_t)DM * DM * 2 <= WS_XN &&
              WS_XN + (size_t)M * DM * 2 <= WS_Y && WS_Y + (size_t)M * DM * 2 <= WS_H && WS_H + (size_t)M * FF * 2 <= WS_KC && WS_KC + (size_t)4 * M * HD * 2 <= WS_VC && WS_VC + (size_t)4 * M * HD * 2 <= WS_END, "d_ws map");
constexpr int CW_SCW = 16384;
constexpr int CW_SCW2 = CW_SCW + 2 * 11008;
constexpr int CW_SCW1 = CW_SCW2 + 4096;
constexpr int CW_SCW1D = CW_SCW1 + 2 * 11008;
static_assert((size_t)(CW_SCW1D + 4096) * 4 <= CTL_ZERO_BYTES, "control words inside the zeroed region");
constexpr int CW_BAR = 1024;
constexpr int RING_OFF = 0, RING_BYTES = 131072;
constexpr int MISC_OFF = RING_BYTES;
constexpr int LDS_BYTES = 147456;

#define GAS __attribute__((address_space(1)))
#define LAS __attribute__((address_space(3)))
typedef unsigned short bf16;
typedef unsigned v4u __attribute__((ext_vector_type(4)));
typedef unsigned v2u __attribute__((ext_vector_type(2)));
typedef float f32x4 __attribute__((ext_vector_type(4)));
typedef float f32x2 __attribute__((ext_vector_type(2)));
#define LDS_WAIT() asm volatile("s_waitcnt lgkmcnt(0)" ::: "memory")
#define VM_WAIT() asm volatile("s_waitcnt vmcnt(0)" ::: "memory")
__device__ __forceinline__ unsigned pk2(float lo, float hi) { unsigned r; asm volatile("v_cvt_pk_bf16_f32 %0, %1, %2" : "=v"(r) : "v"(lo), "v"(hi)); return r; }
__device__ __forceinline__ float bflo(unsigned w) { return __uint_as_float(w << 16); }
__device__ __forceinline__ float bfhi(unsigned w) { return __uint_as_float(w & 0xffff0000u); }
__device__ __forceinline__ float wave_sum(float v) {
#pragma unroll
    for (int o = 1; o < 64; o <<= 1) v += __shfl_xor(v, o);
    return v;
}
#define XB_TMO      128
#define XB_XCNT(j)  (256  + 64 * (j))
#define XB_XSUB(j)  (1280 + 64 * (j))
#define XB_XGEN(j)  (2304 + 64 * (j))
#define XB_TOP      3328
#define XB_TOPGEN   3392
#define XCD_BAR_WORDS 3456
#define XB_SPIN_CAP (1u << 18)

__device__ __forceinline__ unsigned xb_ld(unsigned* p)              { return __hip_atomic_load(p, __ATOMIC_RELAXED, __HIP_MEMORY_SCOPE_AGENT); }
__device__ __forceinline__ unsigned xb_add(unsigned* p, unsigned v) { return __hip_atomic_fetch_add(p, v, __ATOMIC_RELAXED, __HIP_MEMORY_SCOPE_AGENT); }
__device__ __forceinline__ unsigned xb_xcc_id() { return (unsigned)__builtin_amdgcn_s_getreg((3 << 11) | 20) & 0xFu; }
#define XB_SPIN(cond, bar) do { unsigned _sp = 0; while (cond) { __builtin_amdgcn_s_sleep(1); \
    if ((++_sp & 255u) == 0u) { if (xb_ld(&(bar)[XB_TMO])) break; if (_sp > XB_SPIN_CAP) { atomicAdd(&(bar)[XB_TMO], 1u); break; } } } } while (0)

struct XcdBarrier {
    unsigned* bar; unsigned x;
    volatile LAS unsigned* st;
};

__device__ __forceinline__ XcdBarrier xcd_barrier_post(unsigned* bar, volatile LAS unsigned* st) {
    XcdBarrier b; b.bar = bar; b.x = xb_xcc_id(); b.st = st;
    if (threadIdx.x == 0) (void)xb_add(&bar[XB_XCNT(b.x)], 1u);
    return b;
}
__device__ __forceinline__ void xcd_barrier_complete(unsigned* bar, unsigned x, unsigned& nloc, unsigned& nx) {
    const unsigned G = gridDim.x * gridDim.y * gridDim.z;
    unsigned sum, cnt, mine, sp = 0u;
    for (;;) {
        sum = 0u; cnt = 0u; mine = 0u;
#pragma unroll
        for (unsigned j = 0; j < 16; ++j) { const unsigned c = xb_ld(&bar[XB_XCNT(j)]); sum += c; cnt += (c > 0u) ? 1u : 0u; mine = (j == x) ? c : mine; }
        if (sum == G) break;
        __builtin_amdgcn_s_sleep(1);
        if ((++sp & 255u) == 0u) { if (xb_ld(&bar[XB_TMO])) break; if (sp > XB_SPIN_CAP) { atomicAdd(&bar[XB_TMO], 1u); break; } }
    }
    nloc = mine > 0u ? mine : 1u; nx = cnt > 0u ? cnt : 1u;
}

__device__ __forceinline__ void xcd_barrier(const XcdBarrier& b) {
    asm volatile("s_waitcnt vmcnt(0)" ::: "memory");
    __syncthreads();
    if (threadIdx.x == 0) {
        unsigned* bar = b.bar;
        __builtin_amdgcn_s_waitcnt(0);
        unsigned nloc = b.st[0], nx = b.st[1];
        if (nloc == 0u) { xcd_barrier_complete(bar, b.x, nloc, nx); b.st[0] = nloc; b.st[1] = nx; }
        const unsigned old = xb_add(&bar[XB_XSUB(b.x)], 1u);
        const unsigned gen = old / nloc;
        if (old + 1u == (gen + 1u) * nloc) {
            __builtin_amdgcn_fence(__ATOMIC_RELEASE, "agent");
            asm volatile("s_waitcnt vmcnt(0)" ::: "memory");
            const unsigned og = xb_add(&bar[XB_TOP], 1u);
            const unsigned tg = og / nx;
            if (og + 1u == (tg + 1u) * nx) xb_add(&bar[XB_TOPGEN], 1u);
            else XB_SPIN(xb_ld(&bar[XB_TOPGEN]) == tg, bar);
            __builtin_amdgcn_fence(__ATOMIC_ACQUIRE, "agent");
            xb_add(&bar[XB_XGEN(b.x)], 1u);
            asm volatile("s_waitcnt vmcnt(0)" ::: "memory");
        } else {
            XB_SPIN(xb_ld(&bar[XB_XGEN(b.x)]) == gen, bar);
            __builtin_amdgcn_fence(__ATOMIC_ACQUIRE, "agent");
            asm volatile("s_waitcnt vmcnt(0)" ::: "memory");
        }
    }
    __syncthreads();
}

__device__ __forceinline__ void transpose_item(const float* W, int K, int N, bf16* WT, int mode, const float* gk, LAS float* scr, int item, int lane) {
    const int nblk = N / 32, kb = item / nblk, nb = item % nblk, k0 = 64 * kb, n0 = 32 * nb;
    const GAS float* src = (const GAS float*)W + (size_t)k0 * N + n0 + (lane & 31);
    const float gl = gk ? gk[k0 + lane] : 1.0f;
#pragma unroll 8
    for (int i = 0; i < 32; ++i) { const int kk = 2 * i + (lane >> 5); scr[kk * 33 + (lane & 31)] = src[(size_t)kk * N] * __shfl(gl, kk); }
    LDS_WAIT(); asm volatile("" ::: "memory");
    const int c = lane & 7;
    const int rb = (mode == 0) ? n0 : ((n0 >> 7) * 256 + (n0 & 127) + (mode == 2 ? 128 : 0));
#pragma unroll
    for (int j = 0; j < 4; ++j) { const int n = (lane >> 3) + 8 * j; const LAS float* s = scr + (8 * c) * 33 + n;
        v4u o; o.x = pk2(s[0 * 33], s[1 * 33]); o.y = pk2(s[2 * 33], s[3 * 33]); o.z = pk2(s[4 * 33], s[5 * 33]); o.w = pk2(s[6 * 33], s[7 * 33]);
        *(GAS v4u*)(WT + (size_t)(rb + n) * K + k0 + 8 * c) = o; }
    LDS_WAIT(); asm volatile("" ::: "memory");
}
constexpr float WD8_SCALE = 64.0f;
__device__ __forceinline__ unsigned pk8x4(const LAS float* sp, int e) { int w = 0; w = __builtin_amdgcn_cvt_pk_fp8_f32(sp[(e + 0) * 33], sp[(e + 1) * 33], w, false); w = __builtin_amdgcn_cvt_pk_fp8_f32(sp[(e + 2) * 33], sp[(e + 3) * 33], w, true); return (unsigned)w; }
__device__ __forceinline__ void transpose_item_fp8(const float* W, int K, int N, unsigned char* WT8, float wscale, LAS float* scr, int item, int lane) {
    const int nblk = N / 32, kb = item / nblk, nb = item % nblk, k0 = 64 * kb, n0 = 32 * nb;
    const GAS float* src = (const GAS float*)W + (size_t)k0 * N + n0 + (lane & 31);
#pragma unroll 8
    for (int i = 0; i < 32; ++i) { const int kk = 2 * i + (lane >> 5); scr[kk * 33 + (lane & 31)] = src[(size_t)kk * N] * wscale; }
    LDS_WAIT(); asm volatile("" ::: "memory");
    const int n = lane >> 1, h = lane & 1; const LAS float* sp = scr + (32 * h) * 33 + n;
    v4u o0, o1;
    o0.x = pk8x4(sp, 0); o0.y = pk8x4(sp, 4); o0.z = pk8x4(sp, 8); o0.w = pk8x4(sp, 12); o1.x = pk8x4(sp, 16); o1.y = pk8x4(sp, 20); o1.z = pk8x4(sp, 24); o1.w = pk8x4(sp, 28);
    GAS v4u* dst = (GAS v4u*)(WT8 + (size_t)(n0 + n) * K + k0 + 32 * h); dst[0] = o0; dst[1] = o1;
    LDS_WAIT(); asm volatile("" ::: "memory");
}
template <int N> __device__ __forceinline__ void wht_inreg(float (&v)[N]) {
#pragma unroll
    for (int st = 1; st < N; st <<= 1)
#pragma unroll
        for (int i = 0; i < N; ++i) if (!(i & st)) { const float a = v[i], b = v[i + st]; v[i] = a + b; v[i + st] = a - b; }
}
template <int MASK> __device__ __forceinline__ float lane_xor(float v) {
    if constexpr (MASK == 1) return __builtin_bit_cast(float, __builtin_amdgcn_mov_dpp(__builtin_bit_cast(int, v), 0xB1  , 0xF, 0xF, true));
    else if constexpr (MASK == 2) return __builtin_bit_cast(float, __builtin_amdgcn_mov_dpp(__builtin_bit_cast(int, v), 0x4E  , 0xF, 0xF, true));
    else if constexpr (MASK == 4) return __builtin_bit_cast(float, __builtin_amdgcn_ds_swizzle(__builtin_bit_cast(int, v), 0x101F  ));
    else return __shfl_xor(v, MASK);
}
template <int N, int MASK> __device__ __forceinline__ void wht_xlane(float (&v)[N], bool upper) {
    const float sg = upper ? -1.0f : 1.0f;
#pragma unroll
    for (int i = 0; i < N; ++i) { const float o = lane_xor<MASK>(v[i]); v[i] = fmaf(v[i], sg, o); }
}
template <bool ROT>
__device__ __forceinline__ void absmax_item(const float* W, int K, int N, const float* gk, unsigned* scw, int item, int lane) {
    const int nblk = N / 32, kb = item / nblk, nb = item % nblk, k0 = 64 * kb, n0 = 32 * nb;
    const GAS float* src = (const GAS float*)W + (size_t)k0 * N + n0 + (lane & 31);
    const float gl = gk ? gk[k0 + lane] : 1.0f; float mx = 0.f;
    if (ROT) { float v[32];
#pragma unroll
        for (int i = 0; i < 32; ++i) { const int kk = 2 * i + (lane >> 5); v[i] = src[(size_t)kk * N] * __shfl(gl, kk); }
        wht_inreg<32>(v); wht_xlane<32, 32>(v, lane >= 32);
#pragma unroll
        for (int i = 0; i < 32; ++i) mx = fmaxf(mx, fabsf(v[i]));
    } else {
#pragma unroll 8
        for (int i = 0; i < 32; ++i) { const int kk = 2 * i + (lane >> 5); mx = fmaxf(mx, fabsf(src[(size_t)kk * N] * __shfl(gl, kk))); }
    }
    mx = fmaxf(mx, __shfl_xor(mx, 32));
    if (lane < 32) atomicMax(scw + n0 + lane, __float_as_uint(mx));
}
__device__ __forceinline__ unsigned pk4_i8(float a, float b, float c, float d) {
    const float MG = 12582912.0f; const unsigned ua = __float_as_uint(a + MG), ub = __float_as_uint(b + MG), uc = __float_as_uint(c + MG), ud = __float_as_uint(d + MG);
    return __builtin_amdgcn_perm(ub, ua, 0x0c0c0400u) | __builtin_amdgcn_perm(ud, uc, 0x04000c0cu); }
template <bool ROT>
__device__ __forceinline__ void transpose_item_i8(const float* W, int K, int N, unsigned char* WT8, int mode, const float* gk, const unsigned* scw, LAS float* scr, int item, int lane) {
    const int nblk = N / 32, kb = item / nblk, nb = item % nblk, k0 = 64 * kb, n0 = 32 * nb;
    const GAS float* src = (const GAS float*)W + (size_t)k0 * N + n0 + (lane & 31);
    const float gl = gk ? gk[k0 + lane] : 1.0f;
#pragma unroll 8
    for (int i = 0; i < 32; ++i) { const int kk = 2 * i + (lane >> 5); scr[kk * 33 + (lane & 31)] = src[(size_t)kk * N] * __shfl(gl, kk); }
    LDS_WAIT(); asm volatile("" ::: "memory");
    const int n = lane >> 1, h = lane & 1; const LAS float* sp = scr + (32 * h) * 33 + n;
    const float q = 127.0f / fmaxf(__uint_as_float(scw[n0 + n]), 1e-30f);
    const int rb = (mode == 0) ? n0 : ((n0 >> 7) * 256 + (n0 & 127) + (mode == 2 ? 128 : 0));
    float v[32];
#pragma unroll
    for (int e = 0; e < 32; ++e) v[e] = sp[e * 33];
    if (ROT) { wht_inreg<32>(v); wht_xlane<32, 1>(v, h != 0); }
    v4u o0, o1;
#define PK8(e) pk4_i8(v[(e) + 0] * q, v[(e) + 1] * q, v[(e) + 2] * q, v[(e) + 3] * q)
    o0.x = PK8(0); o0.y = PK8(4); o0.z = PK8(8); o0.w = PK8(12); o1.x = PK8(16); o1.y = PK8(20); o1.z = PK8(24); o1.w = PK8(28);
#undef PK8
    GAS v4u* dst = (GAS v4u*)(WT8 + (size_t)(rb + n) * K + k0 + 32 * h); dst[0] = o0; dst[1] = o1;
    LDS_WAIT(); asm volatile("" ::: "memory");
}
constexpr int I_GU = (DM / 64) * (FF / 32), I_D = (FF / 64) * (DM / 32), I_IN = (DM / 64) * (NPROJ / 32), I_OUT = (DM / 64) * (DM / 32);
template <bool DOWN_FP8>
__device__ __forceinline__ void convert_ffn_item(int r, const float* Wg, const float* Wu, const float* Wd, const float* gpre, bf16* WA, bf16* WD, LAS float* scr, int lane) {
    if (r < I_GU) { transpose_item(Wg, DM, FF, WA, 1, gpre, scr, r, lane); return; } r -= I_GU;
    if (r < I_GU) { transpose_item(Wu, DM, FF, WA, 2, gpre, scr, r, lane); return; } r -= I_GU;
    if (DOWN_FP8) transpose_item_fp8(Wd, FF, DM, (unsigned char*)WD, WD8_SCALE, scr, r, lane);
    else transpose_item(Wd, FF, DM, WD, 0, nullptr, scr, r, lane);
}

template <bool QOUT>
__device__ __forceinline__ void xb_row(const float* xrow, bf16* orow, float* rinv, int lane, unsigned char* xqrow) {
    const GAS f32x4* xr = (const GAS f32x4*)xrow + lane;
    f32x4 v[16]; float ss = 0.f;
#pragma unroll
    for (int j = 0; j < 16; ++j) { v[j] = xr[64 * j]; ss += (v[j].x * v[j].x + v[j].y * v[j].y) + (v[j].z * v[j].z + v[j].w * v[j].w); }
    GAS v2u* o8 = (GAS v2u*)orow + lane;
#pragma unroll
    for (int j = 0; j < 16; ++j) { v2u o; o.x = pk2(v[j].x, v[j].y); o.y = pk2(v[j].z, v[j].w); o8[64 * j] = o; }
    float r = 1.0f / sqrtf(wave_sum(ss) * (1.f / DM) + EPS);
    if (QOUT) { float mx = 0.f;
#pragma unroll
        for (int j = 0; j < 16; ++j) mx = fmaxf(fmaxf(mx, fmaxf(fabsf(v[j].x), fabsf(v[j].y))), fmaxf(fabsf(v[j].z), fabsf(v[j].w)));
#pragma unroll
        for (int o = 1; o < 64; o <<= 1) mx = fmaxf(mx, __shfl_xor(mx, o));
        mx = fmaxf(mx, 1e-30f); const float q = 127.0f / mx; GAS unsigned* o4 = (GAS unsigned*)xqrow + lane;
#pragma unroll
        for (int j = 0; j < 16; ++j) o4[64 * j] = pk4_i8(v[j].x * q, v[j].y * q, v[j].z * q, v[j].w * q);
        r *= mx * (1.0f / 127.0f); }
    if (lane == 0) *rinv = r;
}
template <bool FINAL, bool QOUT = false>
__device__ __forceinline__ void resid_row(bf16* xbrow, const bf16* yrow, const float* gpost, float s, float* outrow, float* rinv, int lane, unsigned char* xqrow = nullptr) {
    const GAS v2u* xr = (const GAS v2u*)xbrow + lane; const GAS v2u* yr = (const GAS v2u*)yrow + lane; const GAS f32x4* gp = (const GAS f32x4*)gpost + lane;
    v2u xw[16]; f32x4 v[16]; float ss = 0.f;
#pragma unroll
    for (int j = 0; j < 16; ++j) { xw[j] = xr[64 * j]; const v2u y = yr[64 * j]; v[j] = (f32x4){bflo(y.x), bfhi(y.x), bflo(y.y), bfhi(y.y)}; ss += (v[j].x * v[j].x + v[j].y * v[j].y) + (v[j].z * v[j].z + v[j].w * v[j].w); }
    const float ry = s / sqrtf(wave_sum(ss) * (1.f / DM) + EPS);
    float sx = 0.f;
#pragma unroll
    for (int j = 0; j < 16; ++j) { const f32x4 x = (f32x4){bflo(xw[j].x), bfhi(xw[j].x), bflo(xw[j].y), bfhi(xw[j].y)}, g = gp[64 * j]; v[j] = x + (v[j] * ry) * g;
        if (FINAL) ((GAS f32x4*)outrow + lane)[64 * j] = v[j];
        else { v2u o; o.x = pk2(v[j].x, v[j].y); o.y = pk2(v[j].z, v[j].w); ((GAS v2u*)xbrow + lane)[64 * j] = o; sx += (v[j].x * v[j].x + v[j].y * v[j].y) + (v[j].z * v[j].z + v[j].w * v[j].w); } }
    if (!FINAL) { float r = 1.0f / sqrtf(wave_sum(sx) * (1.f / DM) + EPS);
        if (QOUT) { float mx = 0.f;
#pragma unroll
            for (int j = 0; j < 16; ++j) mx = fmaxf(fmaxf(mx, fmaxf(fabsf(v[j].x), fabsf(v[j].y))), fmaxf(fabsf(v[j].z), fabsf(v[j].w)));
#pragma unroll
            for (int o = 1; o < 64; o <<= 1) mx = fmaxf(mx, __shfl_xor(mx, o));
            mx = fmaxf(mx, 1e-30f); const float q = 127.0f / mx; GAS unsigned* o4 = (GAS unsigned*)xqrow + lane;
#pragma unroll
            for (int j = 0; j < 16; ++j) o4[64 * j] = pk4_i8(v[j].x * q, v[j].y * q, v[j].z * q, v[j].w * q);
            r *= mx * (1.0f / 127.0f); }
        if (lane == 0) *rinv = r; }
}
__device__ __forceinline__ void unpack8(const v4u w, float (&f)[8]) { f[0] = bflo(w.x); f[1] = bfhi(w.x); f[2] = bflo(w.y); f[3] = bfhi(w.y); f[4] = bflo(w.z); f[5] = bfhi(w.z); f[6] = bflo(w.w); f[7] = bfhi(w.w); }
__device__ __forceinline__ void qk_prep_row(bf16* prow, bf16* krow, size_t kstride, int t, const float* qn, const float* kn, const float* rope, int lane, float qc) {
    const int hg = lane >> 3, c8 = lane & 7;
    const int pos = (c8 < 4) ? (t >> 6) : (t & 63), k0 = (c8 & 3) * 8;
    const GAS f32x4* rp = (const GAS f32x4*)(rope + (size_t)(pos * 32 + k0) * 2);
    const f32x4 r0 = rp[0], r1 = rp[1], r2 = rp[2], r3 = rp[3];
    const float cs[8] = {r0.x, r0.z, r1.x, r1.z, r2.x, r2.z, r3.x, r3.z}, sn[8] = {r0.y, r0.w, r1.y, r1.w, r2.y, r2.w, r3.y, r3.w};
    v4u av[3], bv[3];
#pragma unroll
    for (int p = 0; p < 3; ++p) { const int head = 8 * p + hg, hc = head < 20 ? head : 19; const GAS v4u* hp = (const GAS v4u*)(prow + hc * HD + 8 * c8); av[p] = hp[0]; bv[p] = hp[8]; }
#pragma unroll
    for (int p = 0; p < 3; ++p) {
        const int head = 8 * p + hg; const bool valid = head < 20; const int hc = valid ? head : 19;
        GAS v4u* hp = (hc < 16) ? (GAS v4u*)(prow + hc * HD + 8 * c8) : (GAS v4u*)(krow + (size_t)(hc - 16) * kstride + 8 * c8);
        float x1[8], x2[8]; unpack8(av[p], x1); unpack8(bv[p], x2);
        float ss = 0.f;
#pragma unroll
        for (int e = 0; e < 8; ++e) ss += x1[e] * x1[e] + x2[e] * x2[e];
        ss += __shfl_xor(ss, 1); ss += __shfl_xor(ss, 2); ss += __shfl_xor(ss, 4);
        const float rinv = (hc < 16 ? qc : 1.0f) / sqrtf(ss * (1.f / HD) + EPS);
        const GAS f32x4* gp = (const GAS f32x4*)((hc < 16 ? qn : kn) + 8 * c8);
        const f32x4 ga0 = gp[0], ga1 = gp[1], gb0 = gp[16], gb1 = gp[17];
        const float g1[8] = {ga0.x, ga0.y, ga0.z, ga0.w, ga1.x, ga1.y, ga1.z, ga1.w}, g2[8] = {gb0.x, gb0.y, gb0.z, gb0.w, gb1.x, gb1.y, gb1.z, gb1.w};
        float o1[8], o2[8];
#pragma unroll
        for (int e = 0; e < 8; ++e) { const float u1 = x1[e] * rinv * g1[e], u2 = x2[e] * rinv * g2[e]; o1[e] = u1 * cs[e] - u2 * sn[e]; o2[e] = u2 * cs[e] + u1 * sn[e]; }
        if (valid) { v4u wa, wb; wa.x = pk2(o1[0], o1[1]); wa.y = pk2(o1[2], o1[3]); wa.z = pk2(o1[4], o1[5]); wa.w = pk2(o1[6], o1[7]);
            wb.x = pk2(o2[0], o2[1]); wb.y = pk2(o2[2], o2[3]); wb.z = pk2(o2[4], o2[5]); wb.w = pk2(o2[6], o2[7]); hp[0] = wa; hp[8] = wb; }
    }
}
__device__ __forceinline__ void v_copy_row(const bf16* prow, bf16* vrow, size_t vstride, int lane) {
    const v4u w = *(const GAS v4u*)(prow + PO_V + 8 * lane);
    *(GAS v4u*)(vrow + (size_t)(lane >> 4) * vstride + 8 * (lane & 15)) = w;
}
__device__ __forceinline__ void conv_row(const bf16* prow, bool has_prev, bool has_next, const float* cw, const float* gc, bf16* aorow, int lane) {
    const bf16* const pprev = has_prev ? prow - NPROJ : prow; const bf16* const pnext = has_next ? prow + NPROJ : prow;
    const float mp = has_prev ? 1.f : 0.f, mn = has_next ? 1.f : 0.f;
    v4u Bv[4], Cc[4], Hc[4], Cp[4], Hp[4], Cn[4], Hn[4];
#pragma unroll
    for (int q = 0; q < 4; ++q) { const int ch = 8 * (lane + 64 * q);
        Bv[q] = *(const GAS v4u*)(prow + PO_B + ch); Cc[q] = *(const GAS v4u*)(prow + PO_C + ch); Hc[q] = *(const GAS v4u*)(prow + PO_H + ch);
        Cp[q] = *(const GAS v4u*)(pprev + PO_C + ch); Hp[q] = *(const GAS v4u*)(pprev + PO_H + ch);
        Cn[q] = *(const GAS v4u*)(pnext + PO_C + ch); Hn[q] = *(const GAS v4u*)(pnext + PO_H + ch); }
    float y[4][8]; float ss = 0.f;
#pragma unroll
    for (int q = 0; q < 4; ++q) { const int ch = 8 * (lane + 64 * q);
        const GAS f32x4* w = (const GAS f32x4*)(cw + ch);
        const f32x4 w0a = w[0], w0b = w[1], w1a = w[CW / 4], w1b = w[CW / 4 + 1], w2a = w[2 * CW / 4], w2b = w[2 * CW / 4 + 1];
        const float w0[8] = {w0a.x, w0a.y, w0a.z, w0a.w, w0b.x, w0b.y, w0b.z, w0b.w}, w1[8] = {w1a.x, w1a.y, w1a.z, w1a.w, w1b.x, w1b.y, w1b.z, w1b.w}, w2[8] = {w2a.x, w2a.y, w2a.z, w2a.w, w2b.x, w2b.y, w2b.z, w2b.w};
        float fb[8], fc[8], fh[8], pc[8], ph[8], nc[8], nh[8]; unpack8(Bv[q], fb); unpack8(Cc[q], fc); unpack8(Hc[q], fh); unpack8(Cp[q], pc); unpack8(Hp[q], ph); unpack8(Cn[q], nc); unpack8(Hn[q], nh);
#pragma unroll
        for (int e = 0; e < 8; ++e) { const float v = fb[e] * (w0[e] * (pc[e] * ph[e] * mp) + w1[e] * (fc[e] * fh[e]) + w2[e] * (nc[e] * nh[e] * mn)); y[q][e] = v; ss += v * v; }
    }
    const float rinv = 1.0f / sqrtf(wave_sum(ss) * (1.f / CW) + EPS);
#pragma unroll
    for (int q = 0; q < 4; ++q) { const int ch = 8 * (lane + 64 * q); const GAS f32x4* g = (const GAS f32x4*)(gc + ch); const f32x4 ga = g[0], gb = g[1];
        v4u o; o.x = pk2(y[q][0] * rinv * ga.x, y[q][1] * rinv * ga.y); o.y = pk2(y[q][2] * rinv * ga.z, y[q][3] * rinv * ga.w); o.z = pk2(y[q][4] * rinv * gb.x, y[q][5] * rinv * gb.y); o.w = pk2(y[q][6] * rinv * gb.z, y[q][7] * rinv * gb.w);
        *(GAS v4u*)(aorow + AW + ch) = o; }
}
__device__ __forceinline__ void attn_norm_row(const bf16* orow, const float* ga, bf16* aorow, int lane) {
    float y[4][8]; float ss = 0.f;
#pragma unroll
    for (int q = 0; q < 4; ++q) { const v4u w = *(const GAS v4u*)(orow + 8 * (lane + 64 * q)); unpack8(w, y[q]);
#pragma unroll
        for (int e = 0; e < 8; ++e) ss += y[q][e] * y[q][e]; }
    const float rinv = 1.0f / sqrtf(wave_sum(ss) * (1.f / AW) + EPS);
#pragma unroll
    for (int q = 0; q < 4; ++q) { const int ch = 8 * (lane + 64 * q); const GAS f32x4* g = (const GAS f32x4*)(ga + ch); const f32x4 g0 = g[0], g1 = g[1];
        v4u o; o.x = pk2(y[q][0] * rinv * g0.x, y[q][1] * rinv * g0.y); o.y = pk2(y[q][2] * rinv * g0.z, y[q][3] * rinv * g0.w); o.z = pk2(y[q][4] * rinv * g1.x, y[q][5] * rinv * g1.y); o.w = pk2(y[q][6] * rinv * g1.z, y[q][7] * rinv * g1.w);
        *(GAS v4u*)(aorow + ch) = o; }
}
typedef _Float16 h2 __attribute__((ext_vector_type(2)));
__device__ __forceinline__ h2 as_h2(unsigned u) { return __builtin_bit_cast(h2, u); }
__device__ __forceinline__ unsigned as_u32(h2 v) { return __builtin_bit_cast(unsigned, v); }
typedef unsigned short us2 __attribute__((ext_vector_type(2)));
__device__ __forceinline__ us2 as_us2(unsigned u) { return __builtin_bit_cast(us2, u); }
__device__ __forceinline__ h2 h2_addsub(h2 a) { h2 d; asm("v_pk_add_f16 %0, %1, %1 op_sel:[0,1] op_sel_hi:[0,1] neg_hi:[0,1]" : "=v"(d) : "v"(a)); return d; }
template <int MASK> __device__ __forceinline__ h2 h2_xlane(h2 v, h2 sg) { const h2 o = as_h2(__float_as_uint(lane_xor<MASK>(__uint_as_float(as_u32(v))))); return v * sg + o; }
__device__ __forceinline__ void hquant_row(const bf16* hrow, unsigned char* hqrow, float* hs, int lane) {
    constexpr int NCH = FF / 8, NIT = (NCH + 63) / 64;
    const GAS v4u* hp = (const GAS v4u*)hrow + lane; v4u raw[NIT]; us2 mx2 = {0, 0};
    const h2 one = {(_Float16)1.f, (_Float16)1.f}, s1 = (lane & 1) ? -one : one, s2 = (lane & 2) ? -one : one, s4 = (lane & 4) ? -one : one;
#pragma unroll
    for (int i = 0; i < NIT; ++i) { const bool ok = lane + 64 * i < NCH; const v4u w = hp[ok ? 64 * i : 0];
        h2 r0 = as_h2(w.x), r1 = as_h2(w.y), r2 = as_h2(w.z), r3 = as_h2(w.w);
        r0 = h2_addsub(r0); r1 = h2_addsub(r1); r2 = h2_addsub(r2); r3 = h2_addsub(r3);
        { const h2 a = r0 + r1, b = r0 - r1, c = r2 + r3, d = r2 - r3; r0 = a; r1 = b; r2 = c; r3 = d; }
        { const h2 a = r0 + r2, b = r0 - r2, c = r1 + r3, d = r1 - r3; r0 = a; r2 = b; r1 = c; r3 = d; }
        r0 = h2_xlane<1>(r0, s1); r1 = h2_xlane<1>(r1, s1); r2 = h2_xlane<1>(r2, s1); r3 = h2_xlane<1>(r3, s1);
        r0 = h2_xlane<2>(r0, s2); r1 = h2_xlane<2>(r1, s2); r2 = h2_xlane<2>(r2, s2); r3 = h2_xlane<2>(r3, s2);
        r0 = h2_xlane<4>(r0, s4); r1 = h2_xlane<4>(r1, s4); r2 = h2_xlane<4>(r2, s4); r3 = h2_xlane<4>(r3, s4);
        raw[i].x = as_u32(r0); raw[i].y = as_u32(r1); raw[i].z = as_u32(r2); raw[i].w = as_u32(r3);
        const unsigned am = ok ? 0x7fff7fffu : 0u;
        mx2 = __builtin_elementwise_max(mx2, as_us2(raw[i].x & am)); mx2 = __builtin_elementwise_max(mx2, as_us2(raw[i].y & am));
        mx2 = __builtin_elementwise_max(mx2, as_us2(raw[i].z & am)); mx2 = __builtin_elementwise_max(mx2, as_us2(raw[i].w & am)); }
    const h2 mxh = as_h2(__builtin_bit_cast(unsigned, mx2)); const _Float16 mlo = mxh.x, mhi = mxh.y;
    float mx = fmaxf((float)mlo, (float)mhi);
#pragma unroll
    for (int o = 1; o < 64; o <<= 1) mx = fmaxf(mx, __shfl_xor(mx, o));
    const _Float16 q16 = (_Float16)fminf(127.0f / fmaxf(mx, 1e-30f), 32768.0f);
    const h2 q2 = {q16, q16}, mg = {(_Float16)1536.f, (_Float16)1536.f};
    GAS v2u* op = (GAS v2u*)hqrow + lane;
#pragma unroll
    for (int i = 0; i < NIT; ++i) {
        const unsigned t0 = as_u32(as_h2(raw[i].x) * q2 + mg), t1 = as_u32(as_h2(raw[i].y) * q2 + mg);
        const unsigned t2 = as_u32(as_h2(raw[i].z) * q2 + mg), t3 = as_u32(as_h2(raw[i].w) * q2 + mg);
        v2u o; o.x = __builtin_amdgcn_perm(t1, t0, 0x06040200u); o.y = __builtin_amdgcn_perm(t3, t2, 0x06040200u);
        if (lane + 64 * i < NCH) op[64 * i] = o; }
    if (lane == 0) *hs = 1.0f / (float)q16;
}
struct AttnUnit { int qrow0, krow0, seq, head; };
__device__ __forceinline__ bool attn_next(int G, int vcu, int i, AttnUnit& u) {
    if (G == 256) {
        if (i >= 8) return false;
        const int x = vcu >> 5, c = vcu & 31;
        if (i < 4) { const int kh = x & 3, hf = x >> 2, uu = hf * 128 + c * 4 + i, g = uu >> 6, qb = uu & 63;
            u.head = kh * 4 + g; u.krow0 = M_PROMPT; u.seq = S_SAMPLE; u.qrow0 = M_PROMPT + qb * 256; }
        else { const int j = (i - 4) >> 1, p = 2 * x + j, b = p >> 2, kh = p & 3, uu = c * 2 + ((i - 4) & 1), g = uu >> 4, qb = uu & 15;
            u.head = kh * 4 + g; u.krow0 = b * S_PROMPT; u.seq = S_PROMPT; u.qrow0 = b * S_PROMPT + qb * 256; }
        return true;
    }
    int L = i * G + vcu; if (L >= 2048) return false;
    if (L < 1024) { u.head = L >> 6; u.krow0 = M_PROMPT; u.seq = S_SAMPLE; u.qrow0 = M_PROMPT + (L & 63) * 256; }
    else { L -= 1024; const int b = L >> 8; u.head = (L >> 4) & 15; u.krow0 = b * S_PROMPT; u.seq = S_PROMPT; u.qrow0 = b * S_PROMPT + (L & 15) * 256; }
    return true;
}

#ifndef ATTN_FAST
#define ATTN_FAST 1
#endif
#ifndef I8_GU1
#define I8_GU1 1
#endif
#ifndef I8_GU2
#define I8_GU2 1
#endif
#ifndef DOWN2_MODE
#define DOWN2_MODE 2
#endif
#define FP8_DOWN2 (DOWN2_MODE == 1)
#ifndef DOWN1_MODE
#define DOWN1_MODE 2
#endif
#if MK_PER_PHASE && DOWN1_MODE == 2
#error "the one-launch-per-phase debug build has no slot for the FFN1 h pass"
#endif
#ifndef PG8_SP2
#define PG8_SP2 true
#endif
#ifndef PG8_ALIGN
#define PG8_ALIGN true
#endif
#ifndef PG8_ALIGN_I8
#define PG8_ALIGN_I8 PG8_ALIGN
#endif
#ifndef ORDER_DOWN
#define ORDER_DOWN pg8::BlockOrder
#endif
#ifndef ORDER_GU
#define ORDER_GU pg8::StaticOrder
#endif
#ifndef ORDER_IO
#define ORDER_IO pg8::StaticOrder
#endif
#ifndef WGM_GU
#define WGM_GU 8
#endif
#ifndef WGM_DOWN
#define WGM_DOWN 2
#endif
struct Args { const float* in[21]; float* out; unsigned char* ws; int ph_lo, ph_hi; };
static_assert(sizeof(Args) == 21 * 8 + 8 + 8 + 8, "Args has no holes");
enum { IN_XP = 0, IN_XS, IN_F1PRE, IN_F1POST, IN_W1G, IN_W1U, IN_W1D, IN_MIXPRE, IN_MIXPOST, IN_WIN, IN_QN, IN_KN, IN_CONVW, IN_AON, IN_CON, IN_WOUT, IN_F2PRE, IN_F2POST, IN_W2G, IN_W2U, IN_W2D };

__device__ __forceinline__ bool attn_scores_bounded(const float* qn, const float* kn, int lane) {
    float gq = fmaxf(fabsf(qn[lane]), fabsf(qn[lane + 64])), gk = fmaxf(fabsf(kn[lane]), fabsf(kn[lane + 64]));
#pragma unroll
    for (int o = 1; o < 64; o <<= 1) { gq = fmaxf(gq, __shfl_xor(gq, o)); gk = fmaxf(gk, __shfl_xor(gk, o)); }
    return __builtin_amdgcn_readfirstlane((int)(128.0f * attn::QC * 1.02f * gq * gk <= 64.0f)) != 0;
}
__global__ void __launch_bounds__(NWAVES * 64, 2) hymba_fwd(Args args) {
    extern __shared__ __attribute__((aligned(16))) unsigned char lds[];
    LAS unsigned char* const L = (LAS unsigned char*)lds;
    volatile LAS unsigned* const MISC = (volatile LAS unsigned*)(L + MISC_OFF);
    const int tid = threadIdx.x, lane = tid & 63, wave = __builtin_amdgcn_readfirstlane(tid >> 6);
    const int G = gridDim.x, bx = blockIdx.x, vcu = (G % 8 == 0) ? (bx % 8) * (G / 8) + bx / 8 : bx;
    const int gw = vcu * NWAVES + wave, NGW = G * NWAVES;
    unsigned char* const ws = args.ws;
    unsigned* const ctl = (unsigned*)(ws + WS_CTL);
    float* const rope = (float*)(ws + WS_ROPE);
    bf16* const WA = (bf16*)(ws + WS_WA); bf16* const WD = (bf16*)(ws + WS_WD); bf16* const WIN = (bf16*)(ws + WS_WIN); bf16* const WOUT = (bf16*)(ws + WS_WOUT);
    bf16* const XB = (bf16*)(ws + WS_XN); float* const RINV = (float*)(ws + WS_RINV); unsigned* const scw = ctl + CW_SCW; unsigned* const scw1 = ctl + CW_SCW1; unsigned char* const XQ = (unsigned char*)args.out; unsigned char* const WQ = (unsigned char*)(ws + WS_WA); unsigned char* const HQ = (unsigned char*)args.out;     bf16* const Y = (bf16*)(ws + WS_Y); bf16* const H = (bf16*)(ws + WS_H); bf16* const PROJ = H; bf16* const OB = Y; bf16* const AO = (bf16*)args.out;
    bf16* const KC = (bf16*)(ws + WS_KC); bf16* const VC = (bf16*)(ws + WS_VC);
    float* const out = args.out;
    for (int u = tid; u < (LDS_BYTES - MISC_OFF) / 4; u += NWAVES * 64) ((LAS unsigned*)(L + MISC_OFF))[u] = 0u;
    __syncthreads();
#if MK_PER_PHASE
#define GRID_BAR() do { } while (0)
#else
    XcdBarrier bar = xcd_barrier_post(ctl + CW_BAR, MISC + 8);
#ifdef PROBE_BARWAIT
    unsigned long long bw_ = 0ull;
    int bwi_ = 0;
#define GRID_BAR() do { const unsigned long long b0_ = __builtin_amdgcn_s_memrealtime(); xcd_barrier(bar); if (((PROBE_BARWAIT) >> bwi_) & 1) bw_ += __builtin_amdgcn_s_memrealtime() - b0_; ++bwi_; } while (0)
#else
#define GRID_BAR() xcd_barrier(bar)
#endif
#endif
    const int lo = args.ph_lo, hi = args.ph_hi;
#define REPEAT(k)
#ifdef PROBE_SPIN_MASK
    unsigned long long tph_ = __builtin_amdgcn_s_memrealtime();
#define PHASE_END(k) do { if ((PROBE_SPIN_MASK >> (k)) & 1) { if (bx == 0 && tid == 0) { const unsigned long long t1_ = __builtin_amdgcn_s_memrealtime(), d_ = t1_ - tph_; \
        while (__builtin_amdgcn_s_memrealtime() - t1_ < d_) __builtin_amdgcn_s_sleep(8); } GRID_BAR(); } tph_ = __builtin_amdgcn_s_memrealtime(); } while (0)
#else
#define PHASE_END(k) do { } while (0)
#endif
#define IN(k) (lo <= (k) && (k) < hi)
#define XROW(m) ((m) < M_PROMPT ? args.in[IN_XP] + (size_t)(m) * DM : args.in[IN_XS] + (size_t)((m) - M_PROMPT) * DM)
    LAS float* const scr = (LAS float*)(L + RING_OFF + wave * 16384);

    if (IN(0)) { REPEAT(0) {
        constexpr int NITEMS = 3 * I_GU + I_IN + I_OUT;
        for (int it = gw; it < NITEMS; it += NGW) {
            int r = it;
#if I8_GU1
            if (r < I_GU) { absmax_item<false>(args.in[IN_W1G], DM, FF, args.in[IN_F1PRE], scw1, r, lane); continue; }
            if (r < 2 * I_GU) { absmax_item<false>(args.in[IN_W1U], DM, FF, args.in[IN_F1PRE], scw1 + FF, r - I_GU, lane); continue; }
#endif
#if DOWN1_MODE == 2
            if (r >= 2 * I_GU && r < 3 * I_GU) { absmax_item<true>(args.in[IN_W1D], FF, DM, nullptr, ctl + CW_SCW1D, r - 2 * I_GU, lane); continue; }
#endif
            if (r < 3 * I_GU) { if (!I8_GU1 || r >= 2 * I_GU) convert_ffn_item<false>(r, args.in[IN_W1G], args.in[IN_W1U], args.in[IN_W1D], args.in[IN_F1PRE], WA, WD, scr, lane); continue; } r -= 3 * I_GU;
            if (r < I_IN) { transpose_item(args.in[IN_WIN], DM, NPROJ, WIN, 0, args.in[IN_MIXPRE], scr, r, lane); continue; } r -= I_IN;
            transpose_item(args.in[IN_WOUT], DM, DM, WOUT, 0, nullptr, scr, r, lane);
        }
        for (int idx = bx * (NWAVES * 64) + tid; idx < 256 * 32; idx += G * NWAVES * 64) {
            const int pos = idx >> 5, k = idx & 31; const float inv = exp2f(-(float)k * (13.287712379549449f / 32.f)), ang = (float)pos * inv;
            rope[2 * idx] = cosf(ang); rope[2 * idx + 1] = sinf(ang); }
        for (int m = gw; m < M; m += NGW) xb_row<I8_GU1 != 0>(XROW(m), XB + (size_t)m * DM, RINV + m, lane, XQ + (size_t)m * DM);
        }
        GRID_BAR();
        PHASE_END(0);
    }
    if (IN(1)) {
#if I8_GU1
        for (int it = gw; it < 2 * I_GU; it += NGW) {
            if (it < I_GU) transpose_item_i8<false>(args.in[IN_W1G], DM, FF, WQ, 1, args.in[IN_F1PRE], scw1, scr, it, lane);
            else transpose_item_i8<false>(args.in[IN_W1U], DM, FF, WQ, 2, args.in[IN_F1PRE], scw1 + FF, scr, it - I_GU, lane);
        }
#endif
#if DOWN1_MODE == 2
        for (int it = gw; it < I_GU; it += NGW) transpose_item_i8<true>(args.in[IN_W1D], FF, DM, (unsigned char*)WD, 0, nullptr, ctl + CW_SCW1D, scr, it, lane);
#endif
#if I8_GU1 || DOWN1_MODE == 2
        GRID_BAR();
#endif
        PHASE_END(1);
    }
    if (IN(2)) {
        pg8::Gemm g{I8_GU1 ? (const bf16*)XQ : XB, I8_GU1 ? (const bf16*)WQ : WA, M, 2 * FF, I8_GU1 ? DM / 2 : DM};     ORDER_GU S; S.init(M, 2 * FF, G, bx, WGM_GU);
        pg8::EpiSwiGLU<false, I8_GU1 != 0, DOWN1_MODE == 2> E{H, FF, RINV, (const float*)scw1, FF};
        REPEAT(2) {
            pg8::gemm_phase<pg8::EpiSwiGLU<false, I8_GU1 != 0, DOWN1_MODE == 2>, ORDER_GU, PG8_ALIGN_I8, PG8_SP2, I8_GU1 ? 2 : 0>(L + RING_OFF, g, S, E); __syncthreads(); }
        GRID_BAR();
        PHASE_END(2);
    }
    if (IN(3)) {
#if DOWN1_MODE == 2
        for (int m = gw; m < M; m += NGW) hquant_row(H + (size_t)m * FF, HQ + (size_t)m * FF, RINV + m, lane);
        GRID_BAR();
#endif
        pg8::Gemm g{DOWN1_MODE == 2 ? (const bf16*)HQ : H, WD, M, DM, DOWN1_MODE ? FF / 2 : FF};   ORDER_DOWN S; S.init(M, DM, G, bx, WGM_DOWN);
        pg8::EpiBf16T<DOWN1_MODE == 2> E{Y, DM, DOWN1_MODE == 2 ? RINV : nullptr, DOWN1_MODE == 2 ? 1.0f / (127.0f * 64.0f) : 1.0f, (const float*)(ctl + CW_SCW1D)};
        REPEAT(3) {
            pg8::gemm_phase<pg8::EpiBf16T<DOWN1_MODE == 2>, ORDER_DOWN, PG8_ALIGN, PG8_SP2, DOWN1_MODE>(L + RING_OFF, g, S, E); __syncthreads(); }
        GRID_BAR();
        PHASE_END(3);
    }
    if (IN(4)) { REPEAT(4) {
        for (int m = gw; m < M; m += NGW) resid_row<false>(XB + (size_t)m * DM, Y + (size_t)m * DM, args.in[IN_F1POST], 0.5f, nullptr, RINV + m, lane);
#if I8_GU2
        for (int it = gw; it < 3 * I_GU; it += NGW) {
            if (it < I_GU) absmax_item<false>(args.in[IN_W2G], DM, FF, args.in[IN_F2PRE], scw, it, lane);
            else if (it < 2 * I_GU) absmax_item<false>(args.in[IN_W2U], DM, FF, args.in[IN_F2PRE], scw + FF, it - I_GU, lane);
            else if (DOWN2_MODE == 2) absmax_item<true>(args.in[IN_W2D], FF, DM, nullptr, ctl + CW_SCW2, it - 2 * I_GU, lane);
            else convert_ffn_item<FP8_DOWN2 != 0>(it, args.in[IN_W2G], args.in[IN_W2U], args.in[IN_W2D], args.in[IN_F2PRE], WA, WD, scr, lane);
        }
#else
        for (int it = gw; it < 3 * I_GU; it += NGW) convert_ffn_item<FP8_DOWN2 != 0>(it, args.in[IN_W2G], args.in[IN_W2U], args.in[IN_W2D], args.in[IN_F2PRE], WA, WD, scr, lane);
#endif
        }
        GRID_BAR();
        PHASE_END(4);
    }
    if (IN(5)) {
        pg8::Gemm g{XB, WIN, M, NPROJ, DM}; ORDER_IO S; S.init(M, NPROJ, G, bx);
        pg8::EpiBf16 E{PROJ, NPROJ, RINV, 1.0f, nullptr};
        REPEAT(5) {
            pg8::gemm_phase<pg8::EpiBf16, ORDER_IO, PG8_ALIGN, PG8_SP2>(L + RING_OFF, g, S, E); __syncthreads(); }
        GRID_BAR();
        PHASE_END(5);
    }
    if (IN(6)) {
        for (int m = gw; m < M; m += NGW) {
            const int t = m < M_PROMPT ? (m & (S_PROMPT - 1)) : m - M_PROMPT, S = m < M_PROMPT ? S_PROMPT : S_SAMPLE;
            conv_row(PROJ + (size_t)m * NPROJ, t > 0, t < S - 1, args.in[IN_CONVW], args.in[IN_CON], AO + (size_t)m * DM, lane);
        }
        VM_WAIT(); __syncthreads();
        for (int m = gw; m < M; m += NGW) {
            const int t = m < M_PROMPT ? (m & (S_PROMPT - 1)) : m - M_PROMPT;
            qk_prep_row(PROJ + (size_t)m * NPROJ, KC + (size_t)m * HD, (size_t)M * HD, t, args.in[IN_QN], args.in[IN_KN], rope, lane, attn::QPRE ? attn::QC : 1.0f);
            v_copy_row(PROJ + (size_t)m * NPROJ, VC + (size_t)m * HD, (size_t)M * HD, lane);
        }
#if I8_GU2
        for (int it = gw; it < 2 * I_GU; it += NGW) {
            if (it < I_GU) transpose_item_i8<false>(args.in[IN_W2G], DM, FF, WQ, 1, args.in[IN_F2PRE], scw, scr, it, lane);
            else transpose_item_i8<false>(args.in[IN_W2U], DM, FF, WQ, 2, args.in[IN_F2PRE], scw + FF, scr, it - I_GU, lane);
        }
#endif
#if I8_GU2 && DOWN2_MODE == 2
        for (int it = gw; it < I_GU; it += NGW) transpose_item_i8<true>(args.in[IN_W2D], FF, DM, (unsigned char*)WD, 0, nullptr, ctl + CW_SCW2, scr, it, lane);
#endif
        GRID_BAR();
        PHASE_END(6);
    }
    if (IN(7)) {
#ifdef PROBE_IDLE_TICKS
        { const unsigned long long t1_ = __builtin_amdgcn_s_memrealtime(); while (__builtin_amdgcn_s_memrealtime() - t1_ < (unsigned long long)(PROBE_IDLE_TICKS)) __builtin_amdgcn_s_sleep(16); }
#endif
        const bool fast = ATTN_FAST && attn::QPRE && attn_scores_bounded(args.in[IN_QN], args.in[IN_KN], lane);
        AttnUnit u;
        REPEAT(7)
        for (int i = 0; attn_next(G, vcu, i, u); ++i) {
            const int kvh = u.head >> 2;
            const bf16* const qp = PROJ + (size_t)u.qrow0 * NPROJ + PO_Q + u.head * HD; const bf16* const kp = KC + ((size_t)kvh * M + u.krow0) * HD; const bf16* const vp = VC + ((size_t)kvh * M + u.krow0) * HD;
            bf16* const op = OB + (size_t)u.qrow0 * AW + u.head * HD;
#ifdef PROBE_PP_T
#define PP_TACC , (unsigned long long*)(ctl + 768)
#else
#define PP_TACC
#endif
            if (fast) attn::attn_pp_body<true>(qp, kp, vp, op, u.seq, (char*)lds + RING_OFF PP_TACC);
            else attn::attn_pp_body<false>(qp, kp, vp, op, u.seq, (char*)lds + RING_OFF PP_TACC);
#undef PP_TACC
            __syncthreads();
        }
        GRID_BAR();
        PHASE_END(7);
    }
    if (IN(8)) {
        REPEAT(8)
        for (int m = gw; m < M; m += NGW) attn_norm_row(OB + (size_t)m * AW, args.in[IN_AON], AO + (size_t)m * DM, lane);
        GRID_BAR();
        PHASE_END(8);
    }
    if (IN(9)) {
        pg8::Gemm g{AO, WOUT, M, DM, DM}; ORDER_IO S; S.init(M, DM, G, bx);
        pg8::EpiBf16 E{Y, DM, nullptr, 1.0f, nullptr};
        REPEAT(9) {
            pg8::gemm_phase<pg8::EpiBf16, ORDER_IO, PG8_ALIGN, PG8_SP2>(L + RING_OFF, g, S, E); __syncthreads(); }
        GRID_BAR();
        PHASE_END(9);
    }
    if (IN(10)) {
        for (int m = gw; m < M; m += NGW) resid_row<false, I8_GU2 != 0>(XB + (size_t)m * DM, Y + (size_t)m * DM, args.in[IN_MIXPOST], 1.0f, nullptr, RINV + m, lane, XQ + (size_t)m * DM);
        GRID_BAR();
        PHASE_END(10);
    }
    if (IN(11)) {
        pg8::Gemm g{I8_GU2 ? (const bf16*)XQ : XB, I8_GU2 ? (const bf16*)WQ : WA, M, 2 * FF, I8_GU2 ? DM / 2 : DM};     ORDER_GU S; S.init(M, 2 * FF, G, bx, WGM_GU);
        pg8::EpiSwiGLU<DOWN2_MODE == 1, I8_GU2 != 0, DOWN2_MODE == 2> E{H, FF, RINV, (const float*)scw, FF};
        REPEAT(11) {
            pg8::gemm_phase<pg8::EpiSwiGLU<DOWN2_MODE == 1, I8_GU2 != 0, DOWN2_MODE == 2>, ORDER_GU, PG8_ALIGN_I8, PG8_SP2, I8_GU2 ? 2 : 0>(L + RING_OFF, g, S, E); __syncthreads(); }
        GRID_BAR();
        PHASE_END(11);
    }
    if (IN(12)) {
#if DOWN2_MODE == 2
        for (int m = gw; m < M; m += NGW) hquant_row(H + (size_t)m * FF, HQ + (size_t)m * FF, RINV + m, lane);
        GRID_BAR();
#endif
        PHASE_END(12);
    }
    if (IN(13)) {
        pg8::Gemm g{DOWN2_MODE == 2 ? (const bf16*)HQ : H, WD, M, DM, DOWN2_MODE ? FF / 2 : FF};   ORDER_DOWN S; S.init(M, DM, G, bx, WGM_DOWN);
        pg8::EpiBf16T<DOWN2_MODE == 2> E{Y, DM, DOWN2_MODE == 2 ? RINV : nullptr, DOWN2_MODE == 1 ? 1.0f / WD8_SCALE : (DOWN2_MODE == 2 ? 1.0f / (127.0f * 64.0f) : 1.0f), (const float*)(ctl + CW_SCW2)};
        REPEAT(13) {
            pg8::gemm_phase<pg8::EpiBf16T<DOWN2_MODE == 2>, ORDER_DOWN, PG8_ALIGN, PG8_SP2, DOWN2_MODE>(L + RING_OFF, g, S, E); __syncthreads(); }
        GRID_BAR();
        PHASE_END(13);
    }
    if (IN(14)) {
        for (int m = gw; m < M; m += NGW) resid_row<true>(XB + (size_t)m * DM, Y + (size_t)m * DM, args.in[IN_F2POST], 0.5f, out + (size_t)m * DM, nullptr, lane);
#ifdef PROBE_SPIN_MASK
        GRID_BAR(); PHASE_END(14);
#endif
    }
#ifdef PROBE_PP_T
    if (bx == 0 && tid == 0) { const unsigned long long d_ = ((unsigned long long*)(ctl + 768))[PROBE_PP_T] >> 4, t1_ = __builtin_amdgcn_s_memrealtime();
        while (__builtin_amdgcn_s_memrealtime() - t1_ < d_) __builtin_amdgcn_s_sleep(8); }
#endif
#ifdef PROBE_BARWAIT
    GRID_BAR();
    if (tid == 0) atomicAdd(ctl + 512, (unsigned)bw_);
    xcd_barrier(bar);
    if (bx == 0 && tid == 0) { const unsigned long long d_ = (unsigned long long)(__hip_atomic_load(ctl + 512, __ATOMIC_RELAXED, __HIP_MEMORY_SCOPE_AGENT) / (unsigned)G), t1_ = __builtin_amdgcn_s_memrealtime();
        while (__builtin_amdgcn_s_memrealtime() - t1_ < d_) __builtin_amdgcn_s_sleep(8); }
#endif
#undef IN
#undef REPEAT
#undef PHASE_END
#undef XROW
#undef GRID_BAR
}

extern "C" void kernel_launch(void* const* d_in, const int* in_sizes, int n_in, void* d_out, int out_size, void* d_ws, size_t ws_size, hipStream_t stream) {
    static int grid = 0;
    if (grid == 0) {
        if (n_in != 21 || in_sizes[0] != M_PROMPT * DM || in_sizes[1] != M_SAMPLE * DM || out_size != M * DM || ws_size < WS_END) {
            fprintf(stderr, "kernel_launch: shape mismatch (n_in %d, out %d, ws %zu < %zu?); nothing launched\n", n_in, out_size, ws_size, (size_t)WS_END); grid = -1; return; }
        int dev = 0, cus = 0;
        if (hipGetDevice(&dev) != hipSuccess || hipDeviceGetAttribute(&cus, hipDeviceAttributeMultiprocessorCount, dev) != hipSuccess) { grid = -1; return; }
        if (hipFuncSetAttribute((const void*)hymba_fwd, hipFuncAttributeMaxDynamicSharedMemorySize, LDS_BYTES) != hipSuccess) { fprintf(stderr, "kernel_launch: hipFuncSetAttribute failed\n"); grid = -1; return; }
        int per_cu = 0;
        if (hipOccupancyMaxActiveBlocksPerMultiprocessor(&per_cu, (const void*)hymba_fwd, NWAVES * 64, LDS_BYTES) != hipSuccess || per_cu < 1)
            fprintf(stderr, "kernel_launch: note: occupancy query reports %d workgroups per CU\n", per_cu);
        (void)hipGetLastError();
        grid = cus;
#ifdef FORCE_GRID
        grid = FORCE_GRID;
#endif
    }
    if (grid < 0) return;
    if (hipMemsetAsync((char*)d_ws + WS_CTL, 0, CTL_ZERO_BYTES, stream) != hipSuccess) return;
    Args a{};
    for (int i = 0; i < 21; ++i) a.in[i] = (const float*)d_in[i];
    a.out = (float*)d_out; a.ws = (unsigned char*)d_ws;
#if MK_PER_PHASE
#ifndef PROBE_REPS
#define PROBE_REPS(k) 1
#endif
    for (int p = 0; p < N_PHASES; ++p) for (int r = 0; r < PROBE_REPS(p); ++r) { a.ph_lo = p; a.ph_hi = p + 1; hipLaunchKernelGGL(hymba_fwd, dim3(grid), dim3(NWAVES * 64), LDS_BYTES, stream, a); }
#else
    a.ph_lo = 0; a.ph_hi = N_PHASES;
    hipLaunchKernelGGL(hymba_fwd, dim3(grid), dim3(NWAVES * 64), LDS_BYTES, stream, a);
#endif
    const hipError_t le = hipPeekAtLastError();
    if (le != hipSuccess) fprintf(stderr, "kernel_launch: launch failed: %s\n", hipGetErrorName(le));
}
```
